# Optimizing an MI355X kernel written in HIP

```python
import math
import jax
import jax.numpy as jnp
from jax import lax
import numpy as np


D_MODEL = 1024
BATCH = 8
SEQ = 4096
DEPTH = 4

N_MIXERS = 3
ROPE_THETA = 500000.0
EPS = 1e-6
Q_BLOCK = 128
MASK_VALUE = -1e30

A_HEADS = 8
A_HEAD_DIM = D_MODEL // A_HEADS // 2
A_V_DIM = 2 * A_HEAD_DIM
A_ROT = A_HEAD_DIM // 4

B_HEADS = 16
B_Q_RANK = 384
B_KV_RANK = 256
B_NOPE = 64
B_ROPE = 32
B_V = 64

C_GROUPS = ((128, 1), (512, 4), (2048, 16))
C_HEADS = 16
C_HEAD_DIM = 64
C_ROT = C_HEAD_DIM // 4
C_BLOCK = 64

FFN_DIM = -(-8 * D_MODEL // (3 * 256)) * 256

N_A = (DEPTH + 2) // 3
N_B = (DEPTH + 1) // 3
N_C = DEPTH // 3

kernel_name = 'hybrid_interleaved_diff_mla_dilated_encoder'


def rms_norm(x, g):
    xf = x.astype(jnp.float32)
    y = xf * lax.rsqrt(jnp.mean(xf * xf, axis=-1, keepdims=True) + EPS) * g.astype(jnp.float32)
    return y.astype(x.dtype)


def rope_tables(seq_len, rot_dim):
    pos = jnp.arange(seq_len, dtype=jnp.float32)
    inv = ROPE_THETA ** (-jnp.arange(0, rot_dim, 2, dtype=jnp.float32) / rot_dim)
    ang = pos[:, None] * inv[None, :]
    return jnp.cos(ang), jnp.sin(ang)


def apply_rope(x, cos, sin):
    r = cos.shape[-1]
    shape = (x.shape[1],) + (1,) * (x.ndim - 3) + (r,)
    c = cos.reshape(shape)
    s = sin.reshape(shape)
    xf = x[..., :2 * r].astype(jnp.float32)
    x1, x2 = xf[..., :r], xf[..., r:]
    rot = jnp.concatenate([x1 * c - x2 * s, x2 * c + x1 * s], axis=-1).astype(x.dtype)
    return jnp.concatenate([rot, x[..., 2 * r:]], axis=-1)


def _to_blocks(t):
    b, h, s, d = t.shape
    return t.reshape(b, h, s // Q_BLOCK, Q_BLOCK, d).transpose(2, 0, 1, 3, 4)


def _from_blocks(t):
    nb, b, h, q, d = t.shape
    return t.transpose(1, 2, 0, 3, 4).reshape(b, h, nb * q, d)


def diff_attention(h, w_qkv, lam_q1, lam_k1, lam_q2, lam_k2, subln, w_o, lambda_init, cos, sin):
    B, S, _ = h.shape
    qk_w = 2 * A_HEADS * A_HEAD_DIM
    qkv = h @ w_qkv
    q = qkv[..., :qk_w].reshape(B, S, 2 * A_HEADS, A_HEAD_DIM)
    k = qkv[..., qk_w:2 * qk_w].reshape(B, S, 2 * A_HEADS, A_HEAD_DIM)
    v = qkv[..., 2 * qk_w:].reshape(B, S, A_HEADS, A_V_DIM)
    q = (apply_rope(q, cos, sin) * (A_HEAD_DIM ** -0.5)).transpose(0, 2, 1, 3)
    k = apply_rope(k, cos, sin).transpose(0, 2, 1, 3)
    v = v.transpose(0, 2, 1, 3)
    lam = (jnp.exp(jnp.sum(lam_q1.astype(jnp.float32) * lam_k1.astype(jnp.float32)))
           - jnp.exp(jnp.sum(lam_q2.astype(jnp.float32) * lam_k2.astype(jnp.float32)))
           + lambda_init)

    def block(qb):
        s = jnp.einsum('bhqd,bhkd->bhqk', qb, k).astype(jnp.float32)
        p = jax.nn.softmax(s, axis=-1).reshape(B, A_HEADS, 2, qb.shape[2], S)
        a = p[:, :, 0] - lam * p[:, :, 1]
        return jnp.einsum('bhqk,bhkd->bhqd', a.astype(v.dtype), v)

    o = _from_blocks(lax.map(block, _to_blocks(q)))
    o = rms_norm(o, subln) * (1.0 - lambda_init)
    o = o.transpose(0, 2, 1, 3).reshape(B, S, A_HEADS * A_V_DIM)
    return o @ w_o


def latent_attention(h, w_a, q_norm, kv_norm, w_qb, w_kvb, w_o, cos, sin):
    B, S, _ = h.shape
    a = h @ w_a
    q_lat = rms_norm(a[..., :B_Q_RANK], q_norm)
    kv_lat = rms_norm(a[..., B_Q_RANK:B_Q_RANK + B_KV_RANK], kv_norm)
    k_rope = apply_rope(a[..., B_Q_RANK + B_KV_RANK:], cos, sin)
    scale = (B_NOPE + B_ROPE) ** -0.5
    q = (q_lat @ w_qb).reshape(B, S, B_HEADS, B_NOPE + B_ROPE)
    q_nope = (q[..., :B_NOPE] * scale).transpose(0, 2, 1, 3)
    q_rope = (apply_rope(q[..., B_NOPE:], cos, sin) * scale).transpose(0, 2, 1, 3)
    kv = (kv_lat @ w_kvb).reshape(B, S, B_HEADS, B_NOPE + B_V)
    k_nope = kv[..., :B_NOPE].transpose(0, 2, 1, 3)
    v = kv[..., B_NOPE:].transpose(0, 2, 1, 3)

    def block(qs):
        qn, qr = qs
        s = (jnp.einsum('bhqd,bhkd->bhqk', qn, k_nope)
             + jnp.einsum('bhqr,bkr->bhqk', qr, k_rope)).astype(jnp.float32)
        p = jax.nn.softmax(s, axis=-1)
        return jnp.einsum('bhqk,bhkd->bhqd', p.astype(v.dtype), v)

    o = _from_blocks(lax.map(block, (_to_blocks(q_nope), _to_blocks(q_rope))))
    o = o.transpose(0, 2, 1, 3).reshape(B, S, B_HEADS * B_V)
    return o @ w_o


def _dilated_group(q, k, v, window, dilation):
    B, S, H, hd = q.shape
    radius = (window // 2) // dilation
    L = S // dilation
    nb = -(-L // C_BLOCK)
    Lp = nb * C_BLOCK

    def phase(t):
        t = t.reshape(B, L, dilation, H, hd).transpose(0, 2, 3, 1, 4)
        return jnp.pad(t, ((0, 0), (0, 0), (0, 0), (0, Lp - L), (0, 0)))

    def band(t):
        t = jnp.pad(phase(t), ((0, 0), (0, 0), (0, 0), (C_BLOCK, C_BLOCK), (0, 0)))
        t = t.reshape(B, dilation, H, nb + 2, C_BLOCK, hd)
        return jnp.concatenate([t[:, :, :, :-2], t[:, :, :, 1:-1], t[:, :, :, 2:]], axis=-2)

    qb = phase(q).reshape(B, dilation, H, nb, C_BLOCK, hd)
    kb, vb = band(k), band(v)
    blk = jnp.arange(nb)[:, None]
    qpos = blk * C_BLOCK + jnp.arange(C_BLOCK)[None, :]
    kpos = (blk - 1) * C_BLOCK + jnp.arange(3 * C_BLOCK)[None, :]
    mask = ((jnp.abs(qpos[:, :, None] - kpos[:, None, :]) <= radius)
            & (kpos[:, None, :] >= 0) & (kpos[:, None, :] < L))
    s = jnp.einsum('bphnqd,bphnkd->bphnqk', qb, kb).astype(jnp.float32)
    s = jnp.where(mask, s, MASK_VALUE)
    lse = jax.nn.logsumexp(s, axis=-1, keepdims=True)
    p = jnp.exp(s - lse)
    o = jnp.einsum('bphnqk,bphnkd->bphnqd', p.astype(v.dtype), vb)
    o = o.reshape(B, dilation, H, Lp, hd)[:, :, :, :L].transpose(0, 3, 1, 2, 4).reshape(B, S, H, hd)
    lse = lse[..., 0].reshape(B, dilation, H, Lp)[..., :L].transpose(0, 3, 1, 2).reshape(B, S, H)
    return o, lse


def dilated_attention(h, w_qkv, w_o, cos, sin):
    B, S, _ = h.shape
    G = len(C_GROUPS)
    qkv = (h @ w_qkv).reshape(B, S, G, 3, C_HEADS, C_HEAD_DIM)
    q = apply_rope(qkv[:, :, :, 0], cos, sin) * (C_HEAD_DIM ** -0.5)
    k = apply_rope(qkv[:, :, :, 1], cos, sin)
    v = qkv[:, :, :, 2]
    outs, lses = [], []
    for g, (window, dilation) in enumerate(C_GROUPS):
        o_g, l_g = _dilated_group(q[:, :, g], k[:, :, g], v[:, :, g], window, dilation)
        outs.append(o_g)
        lses.append(l_g)
    wts = jax.nn.softmax(jnp.stack(lses, axis=0), axis=0)
    o = jnp.sum(wts[..., None].astype(v.dtype) * jnp.stack(outs, axis=0), axis=0)
    return o.reshape(B, S, C_HEADS * C_HEAD_DIM) @ w_o


def swiglu(h, w_gu, w_out):
    gu = h @ w_gu
    return (jax.nn.silu(gu[..., :FFN_DIM]) * gu[..., FFN_DIM:]) @ w_out


def _w(k, shape, fan_in):
    return jax.random.normal(k, shape, jnp.float32) * (fan_in ** -0.5)


def _gain(k, shape):
    return 1.0 + 0.02 * jax.random.normal(k, shape, jnp.float32)


def setup_inputs(seed: int = 0) -> dict:
    key = jax.random.key(seed)
    ks = jax.random.split(key, 21)
    D = D_MODEL
    a_qkv = 2 * 2 * A_HEADS * A_HEAD_DIM + A_HEADS * A_V_DIM
    c_qkv = len(C_GROUPS) * 3 * C_HEADS * C_HEAD_DIM
    return {
        'x': jax.random.normal(ks[0], (BATCH, SEQ, D), jnp.float32),
        'attn_norm': _gain(ks[1], (DEPTH, D)),
        'ffn_norm': _gain(ks[2], (DEPTH, D)),
        'final_norm': _gain(ks[3], (D,)),
        'a_w_qkv': _w(ks[4], (N_A, D, a_qkv), D),
        'a_lambda_q1': 0.1 * jax.random.normal(ks[5], (N_A, A_HEAD_DIM), jnp.float32),
        'a_lambda_k1': 0.1 * jax.random.normal(ks[6], (N_A, A_HEAD_DIM), jnp.float32),
        'a_lambda_q2': 0.1 * jax.random.normal(ks[7], (N_A, A_HEAD_DIM), jnp.float32),
        'a_lambda_k2': 0.1 * jax.random.normal(ks[8], (N_A, A_HEAD_DIM), jnp.float32),
        'a_subln': _gain(ks[9], (N_A, A_V_DIM)),
        'a_w_o': _w(ks[10], (N_A, A_HEADS * A_V_DIM, D), A_HEADS * A_V_DIM),
        'b_w_a': _w(ks[11], (N_B, D, B_Q_RANK + B_KV_RANK + B_ROPE), D),
        'b_q_norm': _gain(ks[12], (N_B, B_Q_RANK)),
        'b_kv_norm': _gain(ks[13], (N_B, B_KV_RANK)),
        'b_w_qb': _w(ks[14], (N_B, B_Q_RANK, B_HEADS * (B_NOPE + B_ROPE)), B_Q_RANK),
        'b_w_kvb': _w(ks[15], (N_B, B_KV_RANK, B_HEADS * (B_NOPE + B_V)), B_KV_RANK),
        'b_w_o': _w(ks[16], (N_B, B_HEADS * B_V, D), B_HEADS * B_V),
        'c_w_qkv': _w(ks[17], (N_C, D, c_qkv), D),
        'c_w_o': _w(ks[18], (N_C, C_HEADS * C_HEAD_DIM, D), C_HEADS * C_HEAD_DIM),
        'f_w_gu': _w(ks[19], (DEPTH, D, 2 * FFN_DIM), D),
        'f_w_out': _w(ks[20], (DEPTH, FFN_DIM, D), FFN_DIM),
    }


def reference(x, attn_norm, ffn_norm, final_norm, a_w_qkv, a_lambda_q1, a_lambda_k1, a_lambda_q2,
              a_lambda_k2, a_subln, a_w_o, b_w_a, b_q_norm, b_kv_norm, b_w_qb, b_w_kvb, b_w_o,
              c_w_qkv, c_w_o, f_w_gu, f_w_out):
    S = x.shape[1]
    cos_p, sin_p = rope_tables(S, A_ROT)
    cos_b, sin_b = rope_tables(S, B_ROPE)
    for i in range(DEPTH):
        m, j = i % N_MIXERS, i // N_MIXERS
        h = rms_norm(x, attn_norm[i])
        if m == 0:
            lambda_init = 0.8 - 0.6 * math.exp(-0.3 * i)
            mix = diff_attention(h, a_w_qkv[j], a_lambda_q1[j], a_lambda_k1[j], a_lambda_q2[j],
                                 a_lambda_k2[j], a_subln[j], a_w_o[j], lambda_init, cos_p, sin_p)
        elif m == 1:
            mix = latent_attention(h, b_w_a[j], b_q_norm[j], b_kv_norm[j], b_w_qb[j], b_w_kvb[j],
                                   b_w_o[j], cos_b, sin_b)
        else:
            mix = dilated_attention(h, c_w_qkv[j], c_w_o[j], cos_p, sin_p)
        x = x + mix
        x = x + swiglu(rms_norm(x, ffn_norm[i]), f_w_gu[i], f_w_out[i])
    return rms_norm(x, final_norm)
```

```cpp
#include <hip/hip_runtime.h>
#include <hip/hip_cooperative_groups.h>
#include <cstdio>
#include <cstdint>
namespace cg = cooperative_groups;
namespace pg8 {
#define PG8_LAS __attribute__((address_space(3)))
typedef unsigned short bf16_t;
typedef short bf16x8 __attribute__((ext_vector_type(8)));
typedef float f32x4 __attribute__((ext_vector_type(4)));
typedef unsigned u32x4 __attribute__((ext_vector_type(4)));
constexpr int BM = 256, BK = 64, HALF = 128, HTB = HALF * BK * 2  , STAGE_BYTES = 8 * HTB, NXCD = 8, WGM = 8;

__host__ __device__ __forceinline__ int lds_byte(int r, int c) { const int st = (r >> 4) * 2 + (c >> 5), rr = r & 15, cc = c & 31, ob = rr * 64 + cc * 2; return st * 1024 + (ob ^ (((ob >> 9) & 1) << 5)); }
__host__ __device__ __forceinline__ void stage_rc(int b, int& R, int& C) { const int st = b / 1024, sb = b % 1024, swz = sb ^ (((sb >> 9) & 1) << 5); R = (st >> 1) * 16 + swz / 64; C = (st & 1) * 32 + (swz % 64) / 2; }
__host__ __device__ __forceinline__ int perm32(int rho) { const int n = rho >> 4, i = rho & 15; return 8 * (i >> 2) + 4 * n + (i & 3); }

struct Unit { int pm, pn; };
struct Gemm { const bf16_t* A; const bf16_t* Bt; int M, N, K, lda, ldb; };

struct StaticOrder {
    int nM, nN, nwg, G, c;
    __host__ __device__ void init(int M, int N, int G_, int c_) { nM = M / BM; nN = N / BM; nwg = nM * nN; G = G_; c = c_; }
    __host__ __device__ bool next(int i, Unit& u) const {
        const long L = (long)i * G + c; if (L >= nwg) return false;
        int wgid = (int)L; { const int q = nwg / NXCD, r = nwg % NXCD, xcd = wgid % NXCD, off = wgid / NXCD; wgid = (xcd < r ? xcd * (q + 1) : r * (q + 1) + (xcd - r) * q) + off; }
        const int nig = WGM * nN, gid = wgid / nig, fm = gid * WGM, gsz = (nM - fm) < WGM ? (nM - fm) : WGM;
        u.pm = fm + ((wgid % nig) % gsz); u.pn = (wgid % nig) / gsz; return true;
    }
    __device__ __forceinline__ void a_ready(const Unit&) const {}
    __device__ __forceinline__ void done(const Unit&) const {}
};

typedef float f32x2 __attribute__((ext_vector_type(2)));
typedef __bf16 bf16x2_t __attribute__((ext_vector_type(2)));
__device__ __forceinline__ unsigned cvt_pk_bf16(float lo, float hi) { f32x2 v = {lo, hi}; bf16x2_t b = __builtin_convertvector(v, bf16x2_t); return __builtin_bit_cast(unsigned, b); }
__device__ __forceinline__ u32x4 pack8(const f32x4 v0, const f32x4 v1) { u32x4 w; w.x = cvt_pk_bf16(v0[0], v0[1]); w.y = cvt_pk_bf16(v0[2], v0[3]); w.z = cvt_pk_bf16(v1[0], v1[1]); w.w = cvt_pk_bf16(v1[2], v1[3]); return w; }
__device__ __forceinline__ f32x4 shx4(const f32x4 v, int mask) { f32x4 r; r[0] = __shfl_xor(v[0], mask); r[1] = __shfl_xor(v[1], mask); r[2] = __shfl_xor(v[2], mask); r[3] = __shfl_xor(v[3], mask); return r; }
__device__ __forceinline__ float xlane16(float v, int fq) { auto rr = __builtin_amdgcn_permlane16_swap(__float_as_uint(v), __float_as_uint(v), false, false); return __uint_as_float((fq & 1) ? rr[0] : rr[1]); }
__device__ __forceinline__ float xlane32(float v, int fq) { auto rr = __builtin_amdgcn_permlane32_swap(__float_as_uint(v), __float_as_uint(v), false, false); return __uint_as_float((fq & 2) ? rr[0] : rr[1]); }
__device__ __forceinline__ f32x4 swp16x4(const f32x4 v, int fq) { f32x4 r; r[0] = xlane16(v[0], fq); r[1] = xlane16(v[1], fq); r[2] = xlane16(v[2], fq); r[3] = xlane16(v[3], fq); return r; }
__device__ __forceinline__ f32x4 swp32x4(const f32x4 v, int fq) { f32x4 r; r[0] = xlane32(v[0], fq); r[1] = xlane32(v[1], fq); r[2] = xlane32(v[2], fq); r[3] = xlane32(v[3], fq); return r; }
constexpr float RMS_EPS = 1e-6f;
typedef unsigned long long ssq_t;
__device__ __forceinline__ float ssq_get(const ssq_t* p, int row) { return (float)p[row] * (1.0f / 65536.0f); }
__device__ __forceinline__ void ssq_add(ssq_t* p, int row, float part) { (void)__hip_atomic_fetch_add(p + row, (ssq_t)(unsigned)(part * 65536.0f + 0.5f), __ATOMIC_RELAXED, __HIP_MEMORY_SCOPE_AGENT); }

struct EpiQKV {
    static constexpr bool PERM = true, AFTER_DRAIN = false;
    bf16_t* O; const ssq_t* ssq; const float* rope; float qscale;
    __device__ __forceinline__ void operator()(const f32x4 (&acc)[2][2][4][2], const Unit& u, int wr, int wc, int fr, int fq) const {
        const int cls = u.pn >> 2; const float sc = cls == 0 ? qscale : 1.f;
        const bool do_rope = (cls < 2) && ((wc & 1) == 0);
#pragma unroll
        for (int ai = 0; ai < 2; ++ai)
#pragma unroll
            for (int m = 0; m < 4; ++m) {
                const int row = u.pm * BM + ai * HALF + wr * 64 + m * 16 + fr;
                const float rinv = __builtin_amdgcn_rsqf(ssq_get(ssq, row) * (1.0f / 1024.0f) + RMS_EPS) * sc;
                f32x4 c0, c1, s0, s1;
                if (do_rope) { const f32x4* tb = (const f32x4*)(rope + (size_t)(row & 4095) * 16); c0 = tb[0]; c1 = tb[1]; s0 = tb[2]; s1 = tb[3]; if (fq == 0) { s0 = -s0; s1 = -s1; } }
#pragma unroll
                for (int bj = 0; bj < 2; ++bj) {
                    f32x4 v0 = acc[ai][bj][m][0] * rinv, v1 = acc[ai][bj][m][1] * rinv;
                    if (do_rope) { const f32x4 p0 = swp16x4(v0, fq), p1 = swp16x4(v1, fq); if (fq < 2) { v0 = v0 * c0 + p0 * s0; v1 = v1 * c1 + p1 * s1; } }
                    *(u32x4*)(O + (size_t)row * 3072 + u.pn * BM + bj * HALF + wc * 32 + 8 * fq) = pack8(v0, v1);
                }
                asm volatile("" ::: "memory");
            }
    }
};
struct EpiScale {
    static constexpr bool PERM = true, AFTER_DRAIN = false;
    bf16_t* O; int ldc; const ssq_t* ssq; float inv_n;
    __device__ __forceinline__ void operator()(const f32x4 (&acc)[2][2][4][2], const Unit& u, int wr, int wc, int fr, int fq) const {
#pragma unroll
        for (int ai = 0; ai < 2; ++ai)
#pragma unroll
            for (int m = 0; m < 4; ++m) {
                const int row = u.pm * BM + ai * HALF + wr * 64 + m * 16 + fr;
                const float rinv = __builtin_amdgcn_rsqf(ssq_get(ssq, row) * inv_n + RMS_EPS);
#pragma unroll
                for (int bj = 0; bj < 2; ++bj)
                    *(u32x4*)(O + (size_t)row * ldc + u.pn * BM + bj * HALF + wc * 32 + 8 * fq) = pack8(acc[ai][bj][m][0] * rinv, acc[ai][bj][m][1] * rinv);
                asm volatile("" ::: "memory");
            }
    }
};
struct EpiMlaQ {
    static constexpr bool PERM = true, AFTER_DRAIN = false;
    bf16_t* O; const ssq_t* ssq; const float* rope; float qscale;
    __device__ __forceinline__ void operator()(const f32x4 (&acc)[2][2][4][2], const Unit& u, int wr, int wc, int fr, int fq) const {
#pragma unroll
        for (int ai = 0; ai < 2; ++ai)
#pragma unroll
            for (int m = 0; m < 4; ++m) {
                const int row = u.pm * BM + ai * HALF + wr * 64 + m * 16 + fr;
                const float rinv = __builtin_amdgcn_rsqf(ssq_get(ssq, row) * (1.0f / 384.0f) + RMS_EPS) * qscale;
#pragma unroll
                for (int bj = 0; bj < 2; ++bj) {
                    const int grp = u.pn * 8 + bj * 4 + wc;
                    f32x4 v0 = acc[ai][bj][m][0] * rinv, v1 = acc[ai][bj][m][1] * rinv;
                    if (grp % 3 == 2) {
                        const f32x4 p0 = swp32x4(v0, fq), p1 = swp32x4(v1, fq);
                        const f32x4* tb = (const f32x4*)(rope + (size_t)(row & 4095) * 32 + 8 * (fq & 1));
                        const f32x4 c0 = tb[0], c1 = tb[1]; f32x4 s0 = tb[4], s1 = tb[5]; if (fq < 2) { s0 = -s0; s1 = -s1; }
                        v0 = v0 * c0 + p0 * s0; v1 = v1 * c1 + p1 * s1;
                    }
                    *(u32x4*)(O + (size_t)row * 1536 + u.pn * BM + bj * HALF + wc * 32 + 8 * fq) = pack8(v0, v1);
                }
                asm volatile("" ::: "memory");
            }
    }
};
struct EpiMlaA {
    static constexpr bool PERM = true, AFTER_DRAIN = false;
    bf16_t* O; bf16_t* KR; const ssq_t* ssq; ssq_t* ssq_q; ssq_t* ssq_kv; const float* rope;
    __device__ __forceinline__ void operator()(const f32x4 (&acc)[2][2][4][2], const Unit& u, int wr, int wc, int fr, int fq) const {
#pragma unroll
        for (int ai = 0; ai < 2; ++ai)
#pragma unroll
            for (int m = 0; m < 4; ++m) {
                const int row = u.pm * BM + ai * HALF + wr * 64 + m * 16 + fr;
                const float rinv = __builtin_amdgcn_rsqf(ssq_get(ssq, row) * (1.0f / 1024.0f) + RMS_EPS);
#pragma unroll
                for (int bj = 0; bj < 2; ++bj) {
                    const int cg = u.pn * BM + bj * HALF + wc * 32;
                    f32x4 v0 = acc[ai][bj][m][0] * rinv, v1 = acc[ai][bj][m][1] * rinv;
                    if (cg < 640) {
                        *(u32x4*)(O + (size_t)row * 768 + cg + 8 * fq) = pack8(v0, v1);
                        float part = (v0[0] * v0[0] + v0[1] * v0[1]) + (v0[2] * v0[2] + v0[3] * v0[3]) + (v1[0] * v1[0] + v1[1] * v1[1]) + (v1[2] * v1[2] + v1[3] * v1[3]);
                        part += __shfl_xor(part, 16); part += __shfl_xor(part, 32);
                        if (fq == 0) ssq_add(cg < 384 ? ssq_q : ssq_kv, row, part);
                    } else if (cg == 640) {
                        const f32x4 p0 = swp32x4(v0, fq), p1 = swp32x4(v1, fq);
                        const f32x4* tb = (const f32x4*)(rope + (size_t)(row & 4095) * 32 + 8 * (fq & 1));
                        const f32x4 c0 = tb[0], c1 = tb[1]; f32x4 s0 = tb[4], s1 = tb[5]; if (fq < 2) { s0 = -s0; s1 = -s1; }
                        v0 = v0 * c0 + p0 * s0; v1 = v1 * c1 + p1 * s1;
                        *(u32x4*)(KR + (size_t)row * 32 + 8 * fq) = pack8(v0, v1);
                    }
                }
                asm volatile("" ::: "memory");
            }
    }
};
struct EpiRes {
    static constexpr bool PERM = true, AFTER_DRAIN = false;
    const float* xin32; float* xout32; bf16_t* xb; int wr_b16; ssq_t* ssq_out;
    __device__ __forceinline__ void operator()(const f32x4 (&acc)[2][2][4][2], const Unit& u, int wr, int wc, int fr, int fq) const {
#pragma unroll
        for (int ai = 0; ai < 2; ++ai)
#pragma unroll
            for (int m = 0; m < 4; ++m) {
                const int row = u.pm * BM + ai * HALF + wr * 64 + m * 16 + fr;
                float part = 0.f;
#pragma unroll
                for (int bj = 0; bj < 2; ++bj) {
                    const size_t off = (size_t)row * 1024 + u.pn * BM + bj * HALF + wc * 32 + 8 * fq;
                    f32x4 a0, a1;
                    if (xin32) { a0 = *(const f32x4*)(xin32 + off); a1 = *(const f32x4*)(xin32 + off + 4); }
                    else { const u32x4 w = *(const u32x4*)(xb + off);
                        a0 = (f32x4){__uint_as_float(w.x << 16), __uint_as_float(w.x & 0xffff0000u), __uint_as_float(w.y << 16), __uint_as_float(w.y & 0xffff0000u)};
                        a1 = (f32x4){__uint_as_float(w.z << 16), __uint_as_float(w.z & 0xffff0000u), __uint_as_float(w.w << 16), __uint_as_float(w.w & 0xffff0000u)}; }
                    const f32x4 v0 = a0 + acc[ai][bj][m][0], v1 = a1 + acc[ai][bj][m][1];
                    if (xout32) { *(f32x4*)(xout32 + off) = v0; *(f32x4*)(xout32 + off + 4) = v1; }
                    if (wr_b16) *(u32x4*)(xb + off) = pack8(v0, v1);
                    part += (v0[0] * v0[0] + v0[1] * v0[1]) + (v0[2] * v0[2] + v0[3] * v0[3]) + (v1[0] * v1[0] + v1[1] * v1[1]) + (v1[2] * v1[2] + v1[3] * v1[3]);
                }
                part += __shfl_xor(part, 16); part += __shfl_xor(part, 32);
                if (fq == 0) ssq_add(ssq_out, row, part);
                asm volatile("" ::: "memory");
            }
    }
};
struct EpiSwiGLU {
    static constexpr bool PERM = true, AFTER_DRAIN = false;
    bf16_t* O; const ssq_t* ssq;
    __device__ __forceinline__ void operator()(const f32x4 (&acc)[2][2][4][2], const Unit& u, int wr, int wc, int fr, int fq) const {
#pragma unroll
        for (int ai = 0; ai < 2; ++ai)
#pragma unroll
            for (int m = 0; m < 4; ++m) {
                const int row = u.pm * BM + ai * HALF + wr * 64 + m * 16 + fr;
                const float rinv = __builtin_amdgcn_rsqf(ssq_get(ssq, row) * (1.0f / 1024.0f) + RMS_EPS);
                f32x4 r[2];
#pragma unroll
                for (int n = 0; n < 2; ++n) {
                    const f32x4 g = acc[ai][0][m][n] * rinv, uu = acc[ai][1][m][n] * rinv;
#pragma unroll
                    for (int e = 0; e < 4; ++e) { const float sg = __builtin_amdgcn_rcpf(1.0f + __builtin_amdgcn_exp2f(g[e] * -1.4426950408889634f)); r[n][e] = g[e] * sg * uu[e]; }
                }
                *(u32x4*)(O + (size_t)row * 2816 + u.pn * HALF + wc * 32 + 8 * fq) = pack8(r[0], r[1]);
                asm volatile("" ::: "memory");
            }
    }
};
template <class Epi, class Sched, bool ALIGN_EPI = false, bool SP2 = false>
__device__ __forceinline__ void gemm_phase(PG8_LAS unsigned char* lds, const Gemm g, const Sched& S, const Epi& E) {
    int tid_ = threadIdx.x; asm volatile("" : "+v"(tid_));
    const int tid = tid_, wid = __builtin_amdgcn_readfirstlane(tid >> 6), lane = tid & 63, wr = wid >> 2, wc = wid & 3, fr = lane & 15, fq = lane >> 4;
    const int K = g.K, nt = K / BK;
    unsigned voffA[2], voffB[2];
#pragma unroll
    for (int i = 0; i < 2; ++i) { int R, C; stage_rc(tid * 16 + i * 8192, R, C); const int Rb = Epi::PERM ? ((R & ~31) + perm32(R & 31)) : R;
        voffA[i] = (unsigned)(R * g.lda + C) * 2u; voffB[i] = (unsigned)(Rb * g.ldb + C) * 2u; }
    const size_t kstep = (size_t)(BK * 2);
    const size_t hstepA = (size_t)HALF * g.lda * 2, hstepB = (size_t)HALF * g.ldb * 2;
    const size_t tstepA = 2 * hstepA, tstepB = 2 * hstepB;
    const unsigned ldsw = (unsigned)wid * 1024u;
    const int aoff = lds_byte(wr * 64 + fr, fq * 8), boff = lds_byte(wc * 32 + fr, fq * 8);
#define PG8_SA(b, h) (((b) * 2 + (h)) * HTB)
#define PG8_SB(b, h) ((4 + (b) * 2 + (h)) * HTB)
#define PG8_STAGE(bufoff, gbase, voff) do { _Pragma("unroll") for (int _i = 0; _i < 2; ++_i) \
        __builtin_amdgcn_global_load_lds((const unsigned*)((const char*)(gbase) + (voff)[_i]), (PG8_LAS unsigned*)(lds + (bufoff) + ldsw + _i * 8192), 16, 0, 0); } while (0)
#define PG8_LDA(dst, b, h) do { _Pragma("unroll") for (int m = 0; m < 4; ++m) _Pragma("unroll") for (int k = 0; k < 2; ++k) dst[m][k] = *(const PG8_LAS bf16x8*)(lds + PG8_SA(b, h) + aoff + m * 2048 + k * 1024); } while (0)
#define PG8_LDB(dst, b, h) do { _Pragma("unroll") for (int n = 0; n < 2; ++n) _Pragma("unroll") for (int k = 0; k < 2; ++k) dst[n][k] = *(const PG8_LAS bf16x8*)(lds + PG8_SB(b, h) + boff + n * 2048 + k * 1024); } while (0)
#define PG8_MMA(ai, bj, At, Bt) do { __builtin_amdgcn_s_setprio(1); _Pragma("unroll") for (int m = 0; m < 4; ++m) _Pragma("unroll") for (int n = 0; n < 2; ++n) _Pragma("unroll") for (int k = 0; k < 2; ++k) \
        acc[ai][bj][m][n] = __builtin_amdgcn_mfma_f32_16x16x32_bf16(Bt[n][k], At[m][k], acc[ai][bj][m][n], 0, 0, 0); __builtin_amdgcn_s_setprio(0); } while (0)
#define PG8_WAIT_V(n) asm volatile("s_waitcnt vmcnt(" #n ")" ::: "memory")
#define PG8_WAIT_L(n) asm volatile("s_waitcnt lgkmcnt(" #n ")" ::: "memory")
#define PG8_BAR __builtin_amdgcn_s_barrier()
#define PG8_SCHED __builtin_amdgcn_sched_barrier(0)
    Unit cur, nxt; int ui = 0;
    if (!S.next(0, cur)) return;
    f32x4 acc[2][2][4][2];
#pragma unroll
    for (int a = 0; a < 2; ++a)
#pragma unroll
        for (int b = 0; b < 2; ++b)
#pragma unroll
            for (int m = 0; m < 4; ++m)
#pragma unroll
                for (int n = 0; n < 2; ++n) acc[a][b][m][n] = (f32x4){0.f, 0.f, 0.f, 0.f};
    bf16x8 At[4][2], B0[2][2], B1[2][2];
    const char* cA = (const char*)g.A + (size_t)cur.pm * tstepA; const char* cB = (const char*)g.Bt + (size_t)cur.pn * tstepB;
    S.a_ready(cur);
    if constexpr (SP2) {
        PG8_STAGE(PG8_SB(0, 0), cB, voffB); PG8_STAGE(PG8_SB(0, 1), cB + hstepB, voffB); PG8_STAGE(PG8_SA(0, 0), cA, voffA); PG8_STAGE(PG8_SA(0, 1), cA + hstepA, voffA);
        if (wr == 1) PG8_BAR;
        PG8_WAIT_V(2); PG8_BAR;
        PG8_STAGE(PG8_SB(1, 0), cB + kstep, voffB); PG8_STAGE(PG8_SA(1, 0), cA + kstep, voffA); PG8_STAGE(PG8_SB(1, 1), cB + hstepB + kstep, voffB);
        PG8_WAIT_V(6); PG8_BAR;
    } else {
        PG8_STAGE(PG8_SB(0, 0), cB, voffB); PG8_STAGE(PG8_SA(0, 0), cA, voffA); PG8_STAGE(PG8_SB(0, 1), cB + hstepB, voffB); PG8_STAGE(PG8_SA(0, 1), cA + hstepA, voffA);
        if (wr == 1) PG8_BAR;
        PG8_WAIT_V(4); PG8_BAR;
        PG8_STAGE(PG8_SB(1, 0), cB + kstep, voffB); PG8_STAGE(PG8_SA(1, 0), cA + kstep, voffA); PG8_STAGE(PG8_SB(1, 1), cB + hstepB + kstep, voffB);
        PG8_WAIT_V(6); PG8_BAR;
    }
    for (;;) {
        const bool has_next = S.next(ui + 1, nxt);
        const char* nA = has_next ? (const char*)g.A + (size_t)nxt.pm * tstepA : cA; const char* nB = has_next ? (const char*)g.Bt + (size_t)nxt.pn * tstepB : cB;
#pragma unroll 1
        for (int t = 0; t < nt; t += 2) {
            const bool last = (t == nt - 2);
            const char* a1 = cA + (size_t)(t + 1) * kstep;
            const char* a2 = last ? nA : cA + (size_t)(t + 2) * kstep; const char* b2 = last ? nB : cB + (size_t)(t + 2) * kstep;
            const char* a3 = a2 + kstep; const char* b3 = b2 + kstep;
            if (last && has_next) S.a_ready(nxt);
            if constexpr (SP2) {
            PG8_LDB(B0, 0, 0); PG8_LDB(B1, 0, 1); PG8_SCHED; PG8_LDA(At, 0, 0); PG8_STAGE(PG8_SA(1, 1), a1 + hstepA, voffA);
            PG8_WAIT_V(8); PG8_WAIT_L(0); PG8_BAR; PG8_MMA(0, 0, At, B0); PG8_MMA(0, 1, At, B1); PG8_BAR; PG8_SCHED;
            PG8_LDA(At, 0, 1); PG8_STAGE(PG8_SB(0, 0), b2, voffB); PG8_STAGE(PG8_SB(0, 1), b2 + hstepB, voffB); PG8_STAGE(PG8_SA(0, 0), a2, voffA);
            PG8_WAIT_V(8); PG8_WAIT_L(0); PG8_BAR; PG8_MMA(1, 0, At, B0); PG8_MMA(1, 1, At, B1); PG8_BAR; PG8_SCHED;
            PG8_LDB(B0, 1, 0); PG8_LDB(B1, 1, 1); PG8_SCHED; PG8_LDA(At, 1, 0); PG8_STAGE(PG8_SA(0, 1), a2 + hstepA, voffA);
            PG8_WAIT_V(8); PG8_WAIT_L(0); PG8_BAR; PG8_MMA(0, 0, At, B0); PG8_MMA(0, 1, At, B1); PG8_BAR; PG8_SCHED;
            PG8_LDA(At, 1, 1); PG8_STAGE(PG8_SB(1, 0), b3, voffB); PG8_STAGE(PG8_SB(1, 1), b3 + hstepB, voffB); PG8_STAGE(PG8_SA(1, 0), a3, voffA);
            PG8_WAIT_V(8); PG8_WAIT_L(0); PG8_BAR; PG8_MMA(1, 0, At, B0); PG8_MMA(1, 1, At, B1); PG8_BAR; PG8_SCHED;
            } else {
            PG8_LDB(B0, 0, 0); PG8_SCHED; PG8_LDA(At, 0, 0); PG8_STAGE(PG8_SA(1, 1), a1 + hstepA, voffA);
            PG8_WAIT_L(8); PG8_BAR; PG8_WAIT_L(0); PG8_MMA(0, 0, At, B0); PG8_BAR; PG8_SCHED;
            PG8_LDB(B1, 0, 1); PG8_STAGE(PG8_SB(0, 0), b2, voffB);
            PG8_BAR; PG8_WAIT_L(0); PG8_MMA(0, 1, At, B1); PG8_BAR;
            PG8_LDA(At, 0, 1); PG8_STAGE(PG8_SA(0, 0), a2, voffA);
            PG8_BAR; PG8_WAIT_L(0); PG8_MMA(1, 0, At, B0); PG8_BAR; PG8_SCHED;
            PG8_STAGE(PG8_SB(0, 1), b2 + hstepB, voffB);
            PG8_WAIT_V(6); PG8_BAR; PG8_MMA(1, 1, At, B1); PG8_BAR;
            PG8_LDB(B0, 1, 0); PG8_SCHED; PG8_LDA(At, 1, 0); PG8_STAGE(PG8_SA(0, 1), a2 + hstepA, voffA);
            PG8_WAIT_L(8); PG8_BAR; PG8_WAIT_L(0); PG8_MMA(0, 0, At, B0); PG8_BAR; PG8_SCHED;
            PG8_LDB(B1, 1, 1); PG8_STAGE(PG8_SB(1, 0), b3, voffB);
            PG8_BAR; PG8_WAIT_L(0); PG8_MMA(0, 1, At, B1); PG8_BAR;
            PG8_LDA(At, 1, 1); PG8_STAGE(PG8_SA(1, 0), a3, voffA);
            PG8_BAR; PG8_WAIT_L(0); PG8_MMA(1, 0, At, B0); PG8_BAR; PG8_SCHED;
            PG8_STAGE(PG8_SB(1, 1), b3 + hstepB, voffB);
            PG8_WAIT_V(6); PG8_BAR; PG8_MMA(1, 1, At, B1); PG8_BAR;
            }
        }
        if constexpr (ALIGN_EPI) { if (wr == 0) PG8_BAR; }
        if constexpr (!Epi::AFTER_DRAIN) { E(acc, cur, wr, wc, fr, fq); S.done(cur); }
        if (!has_next) break;
#pragma unroll
        for (int a = 0; a < 2; ++a)
#pragma unroll
            for (int b = 0; b < 2; ++b)
#pragma unroll
                for (int m = 0; m < 4; ++m)
#pragma unroll
                    for (int n = 0; n < 2; ++n) acc[a][b][m][n] = (f32x4){0.f, 0.f, 0.f, 0.f};
        cur = nxt; cA = nA; cB = nB; ++ui;
        if constexpr (ALIGN_EPI) { if (wr == 1) PG8_BAR; }
    }
    PG8_WAIT_V(0);
    if constexpr (!ALIGN_EPI) { if (wr == 0) PG8_BAR; }
    PG8_BAR;
    if constexpr (Epi::AFTER_DRAIN) { E.fused(acc, cur, wr, wc, fr, fq, lds, wid, lane); S.done(cur); }
#undef PG8_SA
#undef PG8_SB
#undef PG8_STAGE
#undef PG8_LDA
#undef PG8_LDB
#undef PG8_MMA
#undef PG8_WAIT_V
#undef PG8_WAIT_L
#undef PG8_BAR
#undef PG8_SCHED
}
}
namespace fa {
typedef unsigned short bf16_t;
typedef short bf16x8 __attribute__((ext_vector_type(8)));
typedef short s16x4 __attribute__((ext_vector_type(4)));
typedef float f32x4 __attribute__((ext_vector_type(4)));
typedef float f32x16 __attribute__((ext_vector_type(16)));
typedef unsigned u32x4 __attribute__((ext_vector_type(4)));
typedef unsigned u32x2 __attribute__((ext_vector_type(2)));
typedef float f32x2 __attribute__((ext_vector_type(2)));
typedef __bf16 bf16x2_t __attribute__((ext_vector_type(2)));
#define FA_LAS __attribute__((address_space(3)))
__device__ __forceinline__ unsigned cvtpk(float lo, float hi) { f32x2 v = {lo, hi}; bf16x2_t b = __builtin_convertvector(v, bf16x2_t); return __builtin_bit_cast(unsigned, b); }
__device__ __forceinline__ float swap_max(float v) { auto rr = __builtin_amdgcn_permlane32_swap(__float_as_uint(v), __float_as_uint(v), false, false); return __builtin_fmaxf(__uint_as_float(rr[0]), __uint_as_float(rr[1])); }
__device__ __forceinline__ float swap_sum(float v) { auto rr = __builtin_amdgcn_permlane32_swap(__float_as_uint(v), __float_as_uint(v), false, false); return __uint_as_float(rr[0]) + __uint_as_float(rr[1]); }
__device__ __forceinline__ int crow(int r, int hi) { return (r & 3) + 8 * (r >> 2) + 4 * hi; }
__device__ __forceinline__ float bf2f(unsigned short b) { return __uint_as_float((unsigned)b << 16); }

struct Src { const bf16_t* k; size_t kpitch; const bf16_t* k2; size_t k2pitch; const bf16_t* v; size_t vpitch; };
template <int DQK, int DV, int KT = 64> struct Cfg {
    static constexpr int RSK = DQK * 2 + 16, RSV = DV * 2 + 64, KBYTES = KT * RSK, VBYTES = KT * RSV, STAGE = KBYTES + VBYTES, NQ = DQK / 16, NO = DV / 32, NS = KT / 64;
};
template <int DQK, int DV, int KT> struct Regs { u32x4 k[KT / 64], k2, v[(DV / 64) * (KT / 64)]; };

template <int DQK, int DV, int KT> __device__ __forceinline__ void tile_load(const Src& s, int tile, int tid, Regs<DQK, DV, KT>& R) {
    const char* kb_ = (const char*)s.k + (size_t)tile * (2 * KT) * s.kpitch;
    const char* vb_ = (const char*)s.v + (size_t)tile * (2 * KT) * s.vpitch;
#pragma unroll
    for (int i = 0; i < KT / 64; ++i) { const unsigned off = (unsigned)((tid >> 3) + 64 * i) * (unsigned)(s.kpitch * 2) + (unsigned)(tid & 7) * 16u; R.k[i] = *(const u32x4*)(kb_ + off); }
    if constexpr (DQK == 96) { if (KT == 128 || tid < 256) { const char* k2b_ = (const char*)s.k2 + (size_t)tile * (2 * KT) * s.k2pitch; const unsigned off = (unsigned)(tid >> 2) * (unsigned)(s.k2pitch * 2) + (unsigned)(tid & 3) * 16u; R.k2 = *(const u32x4*)(k2b_ + off); } }
    if constexpr (DV == 128) {
#pragma unroll
        for (int i = 0; i < 2 * (KT / 64); ++i) { const unsigned off = (unsigned)((tid >> 4) + 32 * i) * (unsigned)(s.vpitch * 2) + (unsigned)(tid & 15) * 16u; R.v[i] = *(const u32x4*)(vb_ + off); }
    } else {
#pragma unroll
        for (int i = 0; i < KT / 64; ++i) { const unsigned off = (unsigned)((tid >> 3) + 64 * i) * (unsigned)(s.vpitch * 2) + (unsigned)(tid & 7) * 16u; R.v[i] = *(const u32x4*)(vb_ + off); }
    }
}
#define FA_SB() __builtin_amdgcn_sched_barrier(0)
template <int DQK, int DV, bool BAND>
__device__ __forceinline__ void tile_compute(const FA_LAS char* kst, const FA_LAS char* vst, const bf16x8 (&qf)[DQK / 16], f32x16 (&o)[DV / 32], float& m, float& l, f32x16& negm, bool first, int lane, int qidx, int kidx0) {
    using C = Cfg<DQK, DV>;
    const int r32 = lane & 31, h = lane >> 5;
    f32x16 p[2];
    const FA_LAS char* kp = kst + r32 * C::RSK + h * 16;
    const FA_LAS char* vp = vst + (4 * h + ((lane & 15) >> 2)) * C::RSV + (16 * ((lane >> 4) & 1) + 4 * (lane & 3)) * 2;
    {
        bf16x8 kf[C::NQ][2];
#pragma unroll
        for (int dd = 0; dd < C::NQ; ++dd)
#pragma unroll
            for (int kb = 0; kb < 2; ++kb) kf[dd][kb] = *(const FA_LAS bf16x8*)(kp + kb * 32 * C::RSK + dd * 32);
        FA_SB();
        __builtin_amdgcn_s_setprio(1);
#pragma unroll
        for (int dd = 0; dd < C::NQ; ++dd)
#pragma unroll
            for (int kb = 0; kb < 2; ++kb) p[kb] = __builtin_amdgcn_mfma_f32_32x32x16_bf16(kf[dd][kb], qf[dd], dd == 0 ? negm : p[kb], 0, 0, 0);
        __builtin_amdgcn_s_setprio(0);
        FA_SB();
    }
    s16x4 vlo[2][C::NO], vhi[2][C::NO];
#pragma unroll
    for (int db = 0; db < C::NO; ++db) {
        vlo[0][db] = __builtin_bit_cast(s16x4, __builtin_amdgcn_ds_read_tr16_b64_v4i16((FA_LAS s16x4*)(vp + 64 * db)));
        vhi[0][db] = __builtin_bit_cast(s16x4, __builtin_amdgcn_ds_read_tr16_b64_v4i16((FA_LAS s16x4*)(vp + 64 * db + 8 * C::RSV)));
    }
    FA_SB();
    if constexpr (BAND) {
#pragma unroll
        for (int kb = 0; kb < 2; ++kb)
#pragma unroll
            for (int r = 0; r < 16; ++r) { const int d = qidx - (kidx0 + 32 * kb + crow(r, h)); if (d > 64 || d < -64) p[kb][r] = -1e30f; }
    }
    float mx = __builtin_fmaxf(__builtin_fmaxf(p[0][0], p[1][0]), p[0][1]);
    float my = __builtin_fmaxf(__builtin_fmaxf(p[1][1], p[0][2]), p[1][2]);
#pragma unroll
    for (int r = 3; r < 15; r += 2) { mx = __builtin_fmaxf(__builtin_fmaxf(mx, p[0][r]), p[1][r]); my = __builtin_fmaxf(__builtin_fmaxf(my, p[0][r + 1]), p[1][r + 1]); }
    mx = __builtin_fmaxf(__builtin_fmaxf(mx, p[0][15]), __builtin_fmaxf(my, p[1][15]));
    mx = swap_max(mx);
    if (first || __any(mx > 8.0f)) {
        const float d = first ? mx : __builtin_fmaxf(mx, 0.f);
        if (!first) {
            const float a = __builtin_amdgcn_exp2f(-d); l *= a;
#pragma unroll
            for (int db = 0; db < C::NO; ++db)
#pragma unroll
                for (int r = 0; r < 16; ++r) o[db][r] *= a;
        }
        m += d;
#pragma unroll
        for (int kb = 0; kb < 2; ++kb)
#pragma unroll
            for (int r = 0; r < 16; ++r) p[kb][r] -= d;
#pragma unroll
        for (int r = 0; r < 16; ++r) negm[r] = -m;
    }
    u32x4 pk[2][2];
    float ls0 = 0.f, ls1 = 0.f;
#pragma unroll
    for (int kb = 0; kb < 2; ++kb)
#pragma unroll
        for (int r = 0; r < 16; r += 2) { const float e0 = __builtin_amdgcn_exp2f(p[kb][r]), e1 = __builtin_amdgcn_exp2f(p[kb][r + 1]); ls0 += e0; ls1 += e1; pk[kb][r >> 3][(r >> 1) & 3] = cvtpk(e0, e1); }
    l += ls0 + ls1;
    FA_SB();
#pragma unroll
    for (int s = 0; s < 4; ++s) {
        if (s + 1 < 4) {
            const int off = (32 * ((s + 1) >> 1) + 16 * ((s + 1) & 1)) * C::RSV;
#pragma unroll
            for (int db = 0; db < C::NO; ++db) {
                vlo[(s + 1) & 1][db] = __builtin_bit_cast(s16x4, __builtin_amdgcn_ds_read_tr16_b64_v4i16((FA_LAS s16x4*)(vp + off + 64 * db)));
                vhi[(s + 1) & 1][db] = __builtin_bit_cast(s16x4, __builtin_amdgcn_ds_read_tr16_b64_v4i16((FA_LAS s16x4*)(vp + off + 64 * db + 8 * C::RSV)));
            }
        }
        FA_SB();
        __builtin_amdgcn_s_setprio(1);
#pragma unroll
        for (int db = 0; db < C::NO; ++db) {
            const s16x4 lo = vlo[s & 1][db], hi = vhi[s & 1][db];
            const bf16x8 vf = {lo[0], lo[1], lo[2], lo[3], hi[0], hi[1], hi[2], hi[3]};
            o[db] = __builtin_amdgcn_mfma_f32_32x32x16_bf16(vf, __builtin_bit_cast(bf16x8, pk[s >> 1][s & 1]), o[db], 0, 0, 0);
        }
        __builtin_amdgcn_s_setprio(0);
        FA_SB();
    }
}
template <int DQK, int DV, int KT> __device__ __forceinline__ void store_k(FA_LAS char* kst, int tid, const Regs<DQK, DV, KT>& R) {
    using C = Cfg<DQK, DV, KT>;
#pragma unroll
    for (int i = 0; i < KT / 64; ++i) { const int r = (tid >> 3) + 64 * i, c = tid & 7; *(FA_LAS u32x4*)(kst + r * C::RSK + c * 16) = R.k[i]; }
    if constexpr (DQK == 96) { if (KT == 128 || tid < 256) { const int r = tid >> 2, c = tid & 3; *(FA_LAS u32x4*)(kst + r * C::RSK + 128 + c * 16) = R.k2; } }
}
template <int DQK, int DV, int KT> __device__ __forceinline__ void store_v(FA_LAS char* vst, int tid, const Regs<DQK, DV, KT>& R) {
    using C = Cfg<DQK, DV, KT>;
    if constexpr (DV == 128) {
#pragma unroll
        for (int i = 0; i < 2 * (KT / 64); ++i) { const int r = (tid >> 4) + 32 * i, c = tid & 15; *(FA_LAS u32x4*)(vst + r * C::RSV + c * 16) = R.v[i]; }
    } else {
#pragma unroll
        for (int i = 0; i < KT / 64; ++i) { const int r = (tid >> 3) + 64 * i, c = tid & 7; *(FA_LAS u32x4*)(vst + r * C::RSV + c * 16) = R.v[i]; }
    }
}
template <int DQK, int DV, bool BAND, int KT>
__device__ __forceinline__ void flash_pass(FA_LAS char* lds, const Src& s, int t0, int t1, const bf16x8 (&qf)[DQK / 16], f32x16 (&o)[DV / 32], float& m, float& l, int qidx, int wlo, int whi) {
    using C = Cfg<DQK, DV, KT>;
    int tid_ = threadIdx.x; asm volatile("" : "+v"(tid_));
    const int tid = tid_, lane = tid & 63;
    Regs<DQK, DV, KT> R;
    f32x16 negm;
#pragma unroll
    for (int r = 0; r < 16; ++r) negm[r] = 0.f;
    m = 0.f;
    const int tfirst = BAND ? (t0 > wlo ? t0 : wlo) : t0;
    tile_load<DQK, DV, KT>(s, t0, tid, R);
    store_k<DQK, DV, KT>(lds, tid, R); store_v<DQK, DV, KT>(lds + C::KBYTES, tid, R);
    if (t0 + 1 < t1) tile_load<DQK, DV, KT>(s, t0 + 1, tid, R);
#pragma unroll 1
    for (int t = t0; t < t1; ++t) {
        const int cur = (t - t0) & 1;
        __syncthreads();
        if (!BAND || (t >= wlo && t <= whi)) {
#pragma unroll
            for (int sub = 0; sub < KT / 64; ++sub)
                tile_compute<DQK, DV, BAND>(lds + cur * C::STAGE + sub * 64 * C::RSK, lds + cur * C::STAGE + C::KBYTES + sub * 64 * C::RSV, qf, o, m, l, negm, t == tfirst && sub == 0, lane, qidx, t * KT + sub * 64);
        }
        if (t + 1 < t1) { FA_LAS char* nx = lds + (cur ^ 1) * C::STAGE; store_k<DQK, DV, KT>(nx, tid, R); store_v<DQK, DV, KT>(nx + C::KBYTES, tid, R); if (t + 2 < t1) tile_load<DQK, DV, KT>(s, t + 2, tid, R); }
    }
    __syncthreads();
}
constexpr float LOG2E = 1.4426950408889634f;

__device__ __forceinline__ void diff_unit(FA_LAS char* lds, const bf16_t* QKV, bf16_t* OB, int b, int hh, int qb, float lam, float post, const float* subln) {
    int tid_ = threadIdx.x; asm volatile("" : "+v"(tid_));
    const int tid = tid_, lane = tid & 63, w = tid >> 6, r32 = lane & 31, h = lane >> 5;
    const size_t tok = (size_t)b * 4096 + qb * 256 + w * 32 + r32;
    FA_LAS u32x4* stash = (FA_LAS u32x4*)(lds + 65536) + tid;
    f32x16 oa[4];
#pragma unroll 1
    for (int map = 0; map < 2; ++map) {
        const int head = 2 * hh + map;
        bf16x8 qf[4];
#pragma unroll
        for (int dd = 0; dd < 4; ++dd) qf[dd] = *(const bf16x8*)(QKV + tok * 3072 + head * 64 + dd * 16 + h * 8);
        const bf16_t* base = QKV + (size_t)b * 4096 * 3072;
        const Src s{base + 1024 + head * 64, 3072, nullptr, 0, base + 2048 + hh * 128, 3072};
#pragma unroll
        for (int db = 0; db < 4; ++db)
#pragma unroll
            for (int r = 0; r < 16; ++r) oa[db][r] = 0.f;
        float m = -1e30f, l = 0.f;
        flash_pass<64, 128, false, 64>(lds, s, 0, 64, qf, oa, m, l, 0, 0, 0);
        const float inv = 1.0f / swap_sum(l);
        if (map == 0) {
#pragma unroll
            for (int db = 0; db < 4; ++db)
#pragma unroll
                for (int r = 0; r < 16; r += 8) { u32x4 w; w.x = cvtpk(oa[db][r] * inv, oa[db][r + 1] * inv); w.y = cvtpk(oa[db][r + 2] * inv, oa[db][r + 3] * inv); w.z = cvtpk(oa[db][r + 4] * inv, oa[db][r + 5] * inv); w.w = cvtpk(oa[db][r + 6] * inv, oa[db][r + 7] * inv); stash[(db * 2 + (r >> 3)) * 512] = w; }
        } else {
            const float c = lam * inv;
#pragma unroll
            for (int db = 0; db < 4; ++db)
#pragma unroll
                for (int r = 0; r < 16; r += 8) { const u32x4 w4 = stash[(db * 2 + (r >> 3)) * 512];
#pragma unroll
                    for (int e = 0; e < 4; ++e) { const unsigned w = w4[e]; oa[db][r + 2 * e] = __uint_as_float(w << 16) - oa[db][r + 2 * e] * c; oa[db][r + 2 * e + 1] = __uint_as_float(w & 0xffff0000u) - oa[db][r + 2 * e + 1] * c; } }
        }
    }
    float ss = 0.f;
#pragma unroll
    for (int db = 0; db < 4; ++db)
#pragma unroll
        for (int r = 0; r < 16; ++r) ss += oa[db][r] * oa[db][r];
    ss = swap_sum(ss);
    const float rinv = __builtin_amdgcn_rsqf(ss * (1.0f / 128.0f) + 1e-6f) * post;
    bf16_t* orow = OB + tok * 1024 + hh * 128;
#pragma unroll
    for (int db = 0; db < 4; ++db)
#pragma unroll
        for (int g4 = 0; g4 < 4; ++g4) {
            const int d0 = 32 * db + 8 * g4 + 4 * h;
            const f32x4 sg = *(const f32x4*)(subln + d0);
            u32x2 wv; wv.x = cvtpk(oa[db][4 * g4] * rinv * sg[0], oa[db][4 * g4 + 1] * rinv * sg[1]); wv.y = cvtpk(oa[db][4 * g4 + 2] * rinv * sg[2], oa[db][4 * g4 + 3] * rinv * sg[3]);
            *(u32x2*)(orow + d0) = wv;
        }
}
__device__ __forceinline__ void mla_unit(FA_LAS char* lds, const bf16_t* Q, const bf16_t* KV, const bf16_t* KR, bf16_t* OB, int b, int hd, int qb) {
    int tid_ = threadIdx.x; asm volatile("" : "+v"(tid_));
    const int tid = tid_, lane = tid & 63, w = tid >> 6, r32 = lane & 31, h = lane >> 5;
    const size_t tok = (size_t)b * 4096 + qb * 256 + w * 32 + r32;
    bf16x8 qf[6];
#pragma unroll
    for (int dd = 0; dd < 6; ++dd) qf[dd] = *(const bf16x8*)(Q + tok * 1536 + hd * 96 + dd * 16 + h * 8);
    const bf16_t* kvb = KV + (size_t)b * 4096 * 2048 + hd * 128;
    const Src s{kvb, 2048, KR + (size_t)b * 4096 * 32, 32, kvb + 64, 2048};
    f32x16 o[2];
#pragma unroll
    for (int db = 0; db < 2; ++db)
#pragma unroll
        for (int r = 0; r < 16; ++r) o[db][r] = 0.f;
    float m = -1e30f, l = 0.f;
    flash_pass<96, 64, false, 64>(lds, s, 0, 64, qf, o, m, l, 0, 0, 0);
    const float inv = 1.0f / swap_sum(l);
    bf16_t* orow = OB + tok * 1024 + hd * 64;
#pragma unroll
    for (int db = 0; db < 2; ++db)
#pragma unroll
        for (int g4 = 0; g4 < 4; ++g4) {
            const int d0 = 32 * db + 8 * g4 + 4 * h;
            u32x2 wv; wv.x = cvtpk(o[db][4 * g4] * inv, o[db][4 * g4 + 1] * inv); wv.y = cvtpk(o[db][4 * g4 + 2] * inv, o[db][4 * g4 + 3] * inv);
            *(u32x2*)(orow + d0) = wv;
        }
}
__device__ __forceinline__ void dil_unit(FA_LAS char* lds, const bf16_t* QKV, bf16_t* OB, float* LSE, int b, int hd, int dil, int p, int q0, bool first) {
    int tid_ = threadIdx.x; asm volatile("" : "+v"(tid_));
    const int tid = tid_, lane = tid & 63, w = tid >> 6, r32 = lane & 31, h = lane >> 5;
    const int qidx = q0 + w * 32 + r32;
    const size_t tok = (size_t)b * 4096 + (size_t)qidx * dil + p;
    bf16x8 qf[4];
#pragma unroll
    for (int dd = 0; dd < 4; ++dd) qf[dd] = *(const bf16x8*)(QKV + tok * 3072 + hd * 64 + dd * 16 + h * 8);
    const bf16_t* base = QKV + ((size_t)b * 4096 + p) * 3072 + hd * 64;
    const Src s{base + 1024, (size_t)3072 * dil, nullptr, 0, base + 2048, (size_t)3072 * dil};
    const int nb = 64 / dil, blk0 = q0 >> 6;
    const int t0 = blk0 > 0 ? blk0 - 1 : 0, t1 = (blk0 + 5 < nb) ? blk0 + 5 : nb;
    const int wb = blk0 + (w >> 1);
    f32x16 o[2];
#pragma unroll
    for (int db = 0; db < 2; ++db)
#pragma unroll
        for (int r = 0; r < 16; ++r) o[db][r] = 0.f;
    float m = -1e30f, l = 0.f;
    flash_pass<64, 64, true, 64>(lds, s, t0, t1, qf, o, m, l, qidx, wb - 1, wb + 1);
    const float lt = swap_sum(l);
    const float lse = m + __builtin_amdgcn_logf(lt);
    float wn = 1.0f / lt, wo = 0.f, lse_new = lse;
    float* lp = LSE + tok * 16 + hd;
    if (!first) {
        const float lo_ = *lp; const float mx = __builtin_fmaxf(lo_, lse);
        const float eo = __builtin_amdgcn_exp2f(lo_ - mx), en = __builtin_amdgcn_exp2f(lse - mx), tot = eo + en;
        wo = eo / tot; wn = en / (tot * lt); lse_new = mx + __builtin_amdgcn_logf(tot);
    }
    if (h == 0) *lp = lse_new;
    bf16_t* orow = OB + tok * 1024 + hd * 64;
#pragma unroll
    for (int db = 0; db < 2; ++db)
#pragma unroll
        for (int g4 = 0; g4 < 4; ++g4) {
            const int d0 = 32 * db + 8 * g4 + 4 * h;
            float v0 = o[db][4 * g4] * wn, v1 = o[db][4 * g4 + 1] * wn, v2 = o[db][4 * g4 + 2] * wn, v3 = o[db][4 * g4 + 3] * wn;
            if (!first) { const u32x2 ov = *(const u32x2*)(orow + d0);
                v0 += wo * bf2f((unsigned short)(ov.x & 0xffffu)); v1 += wo * bf2f((unsigned short)(ov.x >> 16)); v2 += wo * bf2f((unsigned short)(ov.y & 0xffffu)); v3 += wo * bf2f((unsigned short)(ov.y >> 16)); }
            u32x2 wv; wv.x = cvtpk(v0, v1); wv.y = cvtpk(v2, v3);
            *(u32x2*)(orow + d0) = wv;
        }
}
struct Regs2 { u32x4 k[2], v[2]; };
__device__ __forceinline__ void dil2_load(const Src& s, int tile, int tl, Regs2& R) {
    const char* kb_ = (const char*)s.k + (size_t)tile * 128 * s.kpitch;
    const char* vb_ = (const char*)s.v + (size_t)tile * 128 * s.vpitch;
#pragma unroll
    for (int i = 0; i < 2; ++i) {
        const unsigned offk = (unsigned)((tl >> 3) + 32 * i) * (unsigned)(s.kpitch * 2) + (unsigned)(tl & 7) * 16u; R.k[i] = *(const u32x4*)(kb_ + offk);
        const unsigned offv = (unsigned)((tl >> 3) + 32 * i) * (unsigned)(s.vpitch * 2) + (unsigned)(tl & 7) * 16u; R.v[i] = *(const u32x4*)(vb_ + offv);
    }
}
__device__ __forceinline__ void dil2_store(FA_LAS char* st, int tl, const Regs2& R) {
    using C = Cfg<64, 64, 64>;
#pragma unroll
    for (int i = 0; i < 2; ++i) { const int r = (tl >> 3) + 32 * i, c = tl & 7;
        *(FA_LAS u32x4*)(st + r * C::RSK + c * 16) = R.k[i]; *(FA_LAS u32x4*)(st + C::KBYTES + r * C::RSV + c * 16) = R.v[i]; }
}
__device__ __forceinline__ void dil2_unit(FA_LAS char* lds, const bf16_t* QKV, bf16_t* OB, float* LSE, int b, int hp, int dil, int p, int q0, bool first) {
    using C = Cfg<64, 64, 64>;
    int tid_ = threadIdx.x; asm volatile("" : "+v"(tid_));
    const int tid = tid_, lane = tid & 63, w = tid >> 6, r32 = lane & 31, h = lane >> 5;
    const int grp = w >> 2, wl = w & 3, tl = tid & 255, hd = 2 * hp + grp;
    FA_LAS char* gl = lds + grp * (2 * C::STAGE);
    const int qidx = q0 + wl * 32 + r32;
    const size_t tok = (size_t)b * 4096 + (size_t)qidx * dil + p;
    bf16x8 qf[4];
#pragma unroll
    for (int dd = 0; dd < 4; ++dd) qf[dd] = *(const bf16x8*)(QKV + tok * 3072 + hd * 64 + dd * 16 + h * 8);
    const bf16_t* base = QKV + ((size_t)b * 4096 + p) * 3072 + hd * 64;
    const Src s{base + 1024, (size_t)3072 * dil, nullptr, 0, base + 2048, (size_t)3072 * dil};
    const int nb = 64 / dil, blk0 = q0 >> 6;
    const int t0 = blk0 > 0 ? blk0 - 1 : 0, t1 = (blk0 + 3 < nb) ? blk0 + 3 : nb;
    const int wb = blk0 + (wl >> 1), wlo = wb - 1, whi = wb + 1;
    f32x16 o[2];
#pragma unroll
    for (int db = 0; db < 2; ++db)
#pragma unroll
        for (int r = 0; r < 16; ++r) o[db][r] = 0.f;
    float m = 0.f, l = 0.f;
    f32x16 negm;
#pragma unroll
    for (int r = 0; r < 16; ++r) negm[r] = 0.f;
    const int tfirst = t0 > wlo ? t0 : wlo;
    Regs2 R;
    dil2_load(s, t0, tl, R);
    dil2_store(gl, tl, R);
    if (t0 + 1 < t1) dil2_load(s, t0 + 1, tl, R);
#pragma unroll 1
    for (int t = t0; t < t1; ++t) {
        const int cur = (t - t0) & 1;
        __syncthreads();
        if (t >= wlo && t <= whi) tile_compute<64, 64, true>(gl + cur * C::STAGE, gl + cur * C::STAGE + C::KBYTES, qf, o, m, l, negm, t == tfirst, lane, qidx, t * 64);
        if (t + 1 < t1) { dil2_store(gl + (cur ^ 1) * C::STAGE, tl, R); if (t + 2 < t1) dil2_load(s, t + 2, tl, R); }
    }
    __syncthreads();
    const float lt = swap_sum(l);
    const float lse = m + __builtin_amdgcn_logf(lt);
    float wn = 1.0f / lt, wo = 0.f, lse_new = lse;
    float* lp = LSE + tok * 16 + hd;
    if (!first) {
        const float lo_ = *lp; const float mx = __builtin_fmaxf(lo_, lse);
        const float eo = __builtin_amdgcn_exp2f(lo_ - mx), en = __builtin_amdgcn_exp2f(lse - mx), tot = eo + en;
        wo = eo / tot; wn = en / (tot * lt); lse_new = mx + __builtin_amdgcn_logf(tot);
    }
    if (h == 0) *lp = lse_new;
    bf16_t* orow = OB + tok * 1024 + hd * 64;
#pragma unroll
    for (int db = 0; db < 2; ++db)
#pragma unroll
        for (int g4 = 0; g4 < 4; ++g4) {
            const int d0 = 32 * db + 8 * g4 + 4 * h;
            float v0 = o[db][4 * g4] * wn, v1 = o[db][4 * g4 + 1] * wn, v2 = o[db][4 * g4 + 2] * wn, v3 = o[db][4 * g4 + 3] * wn;
            if (!first) { const u32x2 ov = *(const u32x2*)(orow + d0);
                v0 += wo * bf2f((unsigned short)(ov.x & 0xffffu)); v1 += wo * bf2f((unsigned short)(ov.x >> 16)); v2 += wo * bf2f((unsigned short)(ov.y & 0xffffu)); v3 += wo * bf2f((unsigned short)(ov.y >> 16)); }
            u32x2 wv; wv.x = cvtpk(v0, v1); wv.y = cvtpk(v2, v3);
            *(u32x2*)(orow + d0) = wv;
        }
}
}
#define GAS __attribute__((address_space(1)))
#define LAS __attribute__((address_space(3)))
typedef unsigned short bf16;
typedef unsigned v4u __attribute__((ext_vector_type(4)));
typedef float f32x4 __attribute__((ext_vector_type(4)));

constexpr int NWAVES = 8;
constexpr int T = 32768, SEQ = 4096, D = 1024, FF = 2816;
constexpr size_t MiB = 1u << 20;
constexpr size_t WS_SSQ = 0, SSQ_BYTES = 2 * MiB;
constexpr size_t WS_ROPEA = 2 * MiB;
constexpr size_t WS_ROPEB = 2 * MiB + 256 * 1024;
constexpr size_t WS_W = 4 * MiB;
constexpr size_t W_AQKV = WS_W;
constexpr size_t W_AWO = W_AQKV + 2 * (size_t)3072 * 1024 * 2;
constexpr size_t W_BWA = W_AWO + 2 * (size_t)1024 * 1024 * 2;
constexpr size_t W_BQB = W_BWA + (size_t)768 * 1024 * 2;
constexpr size_t W_BKVB = W_BQB + (size_t)1536 * 384 * 2;
constexpr size_t W_BWO = W_BKVB + (size_t)2048 * 256 * 2;
constexpr size_t W_CQKV = W_BWO + (size_t)1024 * 1024 * 2;
constexpr size_t W_CWO = W_CQKV + (size_t)9216 * 1024 * 2;
constexpr size_t W_GU = W_CWO + (size_t)1024 * 1024 * 2;
constexpr size_t W_OUT = W_GU + 4 * (size_t)5632 * 1024 * 2;
constexpr size_t W_END = W_OUT + 4 * (size_t)1024 * 2816 * 2;
static_assert(W_END <= 112 * MiB, "weights");
constexpr size_t WS_XB = 112 * MiB;
constexpr size_t WS_OB = 176 * MiB;
constexpr size_t WS_QKV = 240 * MiB;
constexpr size_t WS_MLAKV = WS_QKV + (size_t)T * 1536 * 2;
constexpr size_t WS_MLAKR = WS_MLAKV + (size_t)T * 2048 * 2;
constexpr size_t WS_LSE = 496 * MiB;
constexpr size_t WS_SSQ2 = 498 * MiB, SSQ2_BYTES = 3 * MiB;
constexpr size_t WS_END = 502 * MiB;
static_assert(WS_MLAKR + (size_t)T * 32 * 2 <= WS_LSE, "qkv region");

constexpr int LDS_BYTES = 131072 + 256;

struct Params {
    const float* in[21];
    float* out; unsigned char* ws;
};

__device__ __forceinline__ unsigned f2bf(float f) { unsigned u = __builtin_bit_cast(unsigned, f); return (u + 0x7fffu + ((u >> 16) & 1u)) >> 16; }
__device__ __forceinline__ unsigned pk2(float lo, float hi) { return f2bf(lo) | (f2bf(hi) << 16); }
__device__ __forceinline__ float wave_sum(float v) {
#pragma unroll
    for (int o = 1; o < 64; o <<= 1) v += __shfl_xor(v, o);
    return v;
}
__device__ __forceinline__ void transpose_item(const float* W, int K, int N, bf16* WT, const float* gain, int mode, LAS float* scr, int item, int lane) {
    const int nblk = N / 32, kb = item / nblk, nb = item % nblk, k0 = 64 * kb, n0 = 32 * nb;
    f32x4 v[8];
#pragma unroll
    for (int i = 0; i < 8; ++i) { const int kk = (lane >> 3) + 8 * i; v[i] = *(const f32x4*)(W + (size_t)(k0 + kk) * N + n0 + 4 * (lane & 7)); }
#pragma unroll
    for (int i = 0; i < 8; ++i) { const int kk = (lane >> 3) + 8 * i; const float g = gain ? gain[k0 + kk] : 1.0f; LAS float* d = scr + kk * 33 + 4 * (lane & 7);
        d[0] = v[i].x * g; d[1] = v[i].y * g; d[2] = v[i].z * g; d[3] = v[i].w * g; }
    asm volatile("s_waitcnt lgkmcnt(0)" ::: "memory");
    int d0 = n0;
    if (mode == 1) { const int f = n0 < FF ? n0 : n0 - FF; d0 = 256 * (f / 128) + (f % 128) + (n0 < FF ? 0 : 128); }
    const int c = lane & 7;
#pragma unroll
    for (int j = 0; j < 4; ++j) { const int n = (lane >> 3) + 8 * j; const LAS float* s = scr + (8 * c) * 33 + n;
        v4u o; o.x = pk2(s[0 * 33], s[1 * 33]); o.y = pk2(s[2 * 33], s[3 * 33]); o.z = pk2(s[4 * 33], s[5 * 33]); o.w = pk2(s[6 * 33], s[7 * 33]);
        *(v4u*)(WT + (size_t)(d0 + n) * K + k0 + 8 * c) = o; }
    asm volatile("s_waitcnt lgkmcnt(0)" ::: "memory");
}
__device__ __forceinline__ void sincos_d(float ang, float& sn, float& cs) {
    double t = (double)ang * 0.15915494309189535; t -= __builtin_rint(t);
    const double r = t * 6.283185307179586, r2 = r * r;
    double s = 1.0 / 51090942171709440000.0, c = 1.0 / 2432902008176640000.0;
    s = s * r2 * -1.0 + 1.0 / 121645100408832000.0;  c = c * r2 * -1.0 + 1.0 / 6402373705728000.0;
    s = s * r2 * -1.0 + 1.0 / 355687428096000.0;     c = c * r2 * -1.0 + 1.0 / 20922789888000.0;
    s = s * r2 * -1.0 + 1.0 / 1307674368000.0;       c = c * r2 * -1.0 + 1.0 / 87178291200.0;
    s = s * r2 * -1.0 + 1.0 / 6227020800.0;          c = c * r2 * -1.0 + 1.0 / 479001600.0;
    s = s * r2 * -1.0 + 1.0 / 39916800.0;            c = c * r2 * -1.0 + 1.0 / 3628800.0;
    s = s * r2 * -1.0 + 1.0 / 362880.0;              c = c * r2 * -1.0 + 1.0 / 40320.0;
    s = s * r2 * -1.0 + 1.0 / 5040.0;                c = c * r2 * -1.0 + 1.0 / 720.0;
    s = s * r2 * -1.0 + 1.0 / 120.0;                 c = c * r2 * -1.0 + 1.0 / 24.0;
    s = s * r2 * -1.0 + 1.0 / 6.0;                   c = c * r2 * -1.0 + 1.0 / 2.0;
    s = s * r2 * -1.0 + 1.0;                         c = c * r2 * -1.0 + 1.0;
    sn = (float)(s * r); cs = (float)c;
}

typedef GAS unsigned gu32;
constexpr size_t WS_BAR = WS_SSQ2 + SSQ2_BYTES;
#define XB_TMO      128
#define XB_XCNT(j)  (256  + 64 * (j))
#define XB_XSUB(j)  (1280 + 64 * (j))
#define XB_XGEN(j)  (2304 + 64 * (j))
#define XB_TOP      3328
#define XB_TOPGEN   3392
#define XCD_BAR_WORDS 3456
#define XB_SPIN_CAP (1u << 18)

__device__ __forceinline__ unsigned xb_ld(unsigned* p)              { return __hip_atomic_load(p, __ATOMIC_RELAXED, __HIP_MEMORY_SCOPE_AGENT); }
__device__ __forceinline__ unsigned xb_add(unsigned* p, unsigned v) { return __hip_atomic_fetch_add(p, v, __ATOMIC_RELAXED, __HIP_MEMORY_SCOPE_AGENT); }
__device__ __forceinline__ unsigned xb_xcc_id() { return (unsigned)__builtin_amdgcn_s_getreg((3 << 11) | 20) & 0xFu; }
#define XB_SPIN(cond, bar) do { unsigned _sp = 0; while (cond) { __builtin_amdgcn_s_sleep(1); \
    if ((++_sp & 255u) == 0u) { if (xb_ld(&(bar)[XB_TMO])) break; if (_sp > XB_SPIN_CAP) { atomicAdd(&(bar)[XB_TMO], 1u); break; } } } } while (0)

struct XcdBarrier {
    unsigned* bar; unsigned x;
    volatile LAS unsigned* st;
};

__device__ __forceinline__ XcdBarrier xcd_barrier_post(unsigned* bar, volatile LAS unsigned* st) {
    XcdBarrier b; b.bar = bar; b.x = xb_xcc_id(); b.st = st;
    if (threadIdx.x == 0) (void)xb_add(&bar[XB_XCNT(b.x)], 1u);
    return b;
}
__device__ __forceinline__ void xcd_barrier_complete(unsigned* bar, unsigned x, unsigned& nloc, unsigned& nx) {
    const unsigned G = gridDim.x * gridDim.y * gridDim.z;
    unsigned sum, cnt, mine, sp = 0u;
    for (;;) {
        sum = 0u; cnt = 0u; mine = 0u;
#pragma unroll
        for (unsigned j = 0; j < 16; ++j) { const unsigned c = xb_ld(&bar[XB_XCNT(j)]); sum += c; cnt += (c > 0u) ? 1u : 0u; mine = (j == x) ? c : mine; }
        if (sum == G) break;
        __builtin_amdgcn_s_sleep(1);
        if ((++sp & 255u) == 0u) { if (xb_ld(&bar[XB_TMO])) break; if (sp > XB_SPIN_CAP) { atomicAdd(&bar[XB_TMO], 1u); break; } }
    }
    nloc = mine > 0u ? mine : 1u; nx = cnt > 0u ? cnt : 1u;
}

__device__ __forceinline__ void xcd_barrier(const XcdBarrier& b) {
    asm volatile("s_waitcnt vmcnt(0)" ::: "memory");
    __syncthreads();
    if (threadIdx.x == 0) {
        unsigned* bar = b.bar;
        __builtin_amdgcn_s_waitcnt(0);
        unsigned nloc = b.st[0], nx = b.st[1];
        if (nloc == 0u) { xcd_barrier_complete(bar, b.x, nloc, nx); b.st[0] = nloc; b.st[1] = nx; }
        const unsigned old = xb_add(&bar[XB_XSUB(b.x)], 1u);
        const unsigned gen = old / nloc;
        if (old + 1u == (gen + 1u) * nloc) {
            __builtin_amdgcn_fence(__ATOMIC_RELEASE, "agent");
            asm volatile("s_waitcnt vmcnt(0)" ::: "memory");
            const unsigned og = xb_add(&bar[XB_TOP], 1u);
            const unsigned tg = og / nx;
            if (og + 1u == (tg + 1u) * nx) xb_add(&bar[XB_TOPGEN], 1u);
            else XB_SPIN(xb_ld(&bar[XB_TOPGEN]) == tg, bar);
            __builtin_amdgcn_fence(__ATOMIC_ACQUIRE, "agent");
            xb_add(&bar[XB_XGEN(b.x)], 1u);
            asm volatile("s_waitcnt vmcnt(0)" ::: "memory");
        } else {
            XB_SPIN(xb_ld(&bar[XB_XGEN(b.x)]) == gen, bar);
            __builtin_amdgcn_fence(__ATOMIC_ACQUIRE, "agent");
            asm volatile("s_waitcnt vmcnt(0)" ::: "memory");
        }
    }
    __syncthreads();
}

__device__ __forceinline__ void xcd_local_barrier(const XcdBarrier& b) {
    asm volatile("s_waitcnt vmcnt(0)" ::: "memory");
    __syncthreads();
    if (threadIdx.x == 0) {
        unsigned* bar = b.bar;
        __builtin_amdgcn_s_waitcnt(0);
        const unsigned nloc = b.st[0];
        const unsigned old = xb_add(&bar[XB_XSUB(b.x)], 1u);
        const unsigned gen = old / nloc;
        if (old + 1u == (gen + 1u) * nloc) xb_add(&bar[XB_XGEN(b.x)], 1u);
        else XB_SPIN(xb_ld(&bar[XB_XGEN(b.x)]) == gen, bar);
        __builtin_amdgcn_fence(__ATOMIC_ACQUIRE, "agent");
        asm volatile("s_waitcnt vmcnt(0)" ::: "memory");
    }
    __syncthreads();
}

template <class E> struct En { static constexpr bool v = true; };
#ifdef OFF_QKV
template <> struct En<pg8::EpiQKV> { static constexpr bool v = false; };
#endif
#ifdef OFF_SCALE
template <> struct En<pg8::EpiScale> { static constexpr bool v = false; };
#endif
#ifdef OFF_MLAQ
template <> struct En<pg8::EpiMlaQ> { static constexpr bool v = false; };
#endif
#ifdef OFF_MLAA
template <> struct En<pg8::EpiMlaA> { static constexpr bool v = false; };
#endif
#ifdef OFF_RES
template <> struct En<pg8::EpiRes> { static constexpr bool v = false; };
#endif
#ifdef OFF_SWI
template <> struct En<pg8::EpiSwiGLU> { static constexpr bool v = false; };
#endif
__global__ void __launch_bounds__(NWAVES * 64) fwd_kernel(Params P) {
    extern __shared__ __attribute__((aligned(16))) unsigned char lds_raw[];
    cg::grid_group grid = cg::this_grid();
    LAS unsigned char* lds = (LAS unsigned char*)lds_raw;
    const int tid = threadIdx.x, lane = tid & 63, wave = __builtin_amdgcn_readfirstlane(tid >> 6);
    const int G = gridDim.x, bx = blockIdx.x;
    if (threadIdx.x < 64) ((LAS unsigned*)(lds + 131072))[threadIdx.x] = 0u;
    __syncthreads();
    XcdBarrier xbar; xbar.bar = (unsigned*)(P.ws + WS_BAR); xbar.x = xb_xcc_id(); xbar.st = (volatile LAS unsigned*)(lds + 131072);
    if (threadIdx.x == 0) ((volatile LAS unsigned*)(lds + 131072))[2] = xb_add(&xbar.bar[XB_XCNT(xbar.x)], 1u);
#define GSYNC() do { XcdBarrier b_ = xbar; asm volatile("" : "+s"(b_.bar), "+s"(b_.x)); xcd_barrier(b_); } while (0)
    const int vcu0 = (G % 8 == 0) ? (bx % 8) * (G / 8) + bx / 8 : bx;
    unsigned char* ws = P.ws;
    pg8::ssq_t* ssq = (pg8::ssq_t*)(ws + WS_SSQ2);
    float* ropeA = (float*)(ws + WS_ROPEA); float* ropeB = (float*)(ws + WS_ROPEB);
    bf16* XB = (bf16*)(ws + WS_XB); bf16* OB = (bf16*)(ws + WS_OB); bf16* QKV = (bf16*)(ws + WS_QKV);
    bf16* MQ = QKV; bf16* MKV = (bf16*)(ws + WS_MLAKV); bf16* MKR = (bf16*)(ws + WS_MLAKR); bf16* ARAW = OB; bf16* ACT = QKV;
    float* LSE = (float*)(ws + WS_LSE);
    const float* x_in = P.in[0]; const float* attn_norm = P.in[1]; const float* ffn_norm = P.in[2]; const float* final_norm = P.in[3];
    float* out = P.out;

#ifndef PRO_REP
#define PRO_REP 1
#endif
#pragma unroll 1
    for (int rep_ = 0; rep_ < PRO_REP; ++rep_) {
        LAS float* scr = (LAS float*)(lds + wave * 16384);
        const int gw = vcu0 * NWAVES + wave, NGW = G * NWAVES;
        constexpr int NITEMS = (int)(((size_t)2 * 1024 * 3072 + 2 * 1024 * 1024 + 1024 * 672 + 384 * 1536 + 256 * 2048 + 1024 * 1024 + 1024 * 9216 + 1024 * 1024 + (size_t)4 * 1024 * 5632 + (size_t)4 * 2816 * 1024) / 2048);
        for (int it = gw; it < NITEMS; it += NGW) {
            int r = it, rr = 0, K = 0, N = 0, mode = 0; const float* src = nullptr; const float* gain = nullptr; bf16* dst = nullptr;
#define SEL(S_, K_, N_, D_, G_, M_) if (r >= 0) { const int ni = ((K_) / 64) * ((N_) / 32); if (r < ni) { src = (S_); K = (K_); N = (N_); dst = (bf16*)(D_); gain = (G_); mode = (M_); rr = r; r = -1; } else r -= ni; }
            SEL(P.in[4], 1024, 3072, ws + W_AQKV, attn_norm + 0 * 1024, 0)
            SEL(P.in[4] + (size_t)1024 * 3072, 1024, 3072, ws + W_AQKV + (size_t)3072 * 1024 * 2, attn_norm + 3 * 1024, 0)
            SEL(P.in[10], 1024, 1024, ws + W_AWO, nullptr, 0)
            SEL(P.in[10] + (size_t)1024 * 1024, 1024, 1024, ws + W_AWO + (size_t)1024 * 1024 * 2, nullptr, 0)
            SEL(P.in[11], 1024, 672, ws + W_BWA, attn_norm + 1 * 1024, 0)
            SEL(P.in[14], 384, 1536, ws + W_BQB, P.in[12], 0)
            SEL(P.in[15], 256, 2048, ws + W_BKVB, P.in[13], 0)
            SEL(P.in[16], 1024, 1024, ws + W_BWO, nullptr, 0)
            SEL(P.in[17], 1024, 9216, ws + W_CQKV, attn_norm + 2 * 1024, 0)
            SEL(P.in[18], 1024, 1024, ws + W_CWO, nullptr, 0)
#pragma unroll
            for (int i = 0; i < 4; ++i) { SEL(P.in[19] + (size_t)i * 1024 * 5632, 1024, 5632, ws + W_GU + (size_t)i * 5632 * 1024 * 2, ffn_norm + i * 1024, 1) }
#pragma unroll
            for (int i = 0; i < 4; ++i) { SEL(P.in[20] + (size_t)i * 2816 * 1024, 2816, 1024, ws + W_OUT + (size_t)i * 1024 * 2816 * 2, nullptr, 0) }
#undef SEL
            transpose_item(src, K, N, dst, gain, mode, scr, rr, lane);
        }
        { v4u* z = (v4u*)(ws + W_BWA + (size_t)672 * 1024 * 2); const int nz = 96 * 1024 * 2 / 16; for (int i = bx * 512 + tid; i < nz; i += G * 512) z[i] = (v4u){0u, 0u, 0u, 0u}; }
        for (int i = bx * 512 + tid; i < 4096 * 24; i += G * 512) {
            const int pos = i / 24, j = i % 24; float sn, cs;
            if (j < 8) { const float inv = (float)exp2(-(double)j * (1.0 / 8.0) * 18.931568569324174); sincos_d((float)pos * inv, sn, cs); ropeA[pos * 16 + j] = cs; ropeA[pos * 16 + 8 + j] = sn; }
            else { const int jj = j - 8; const float inv = (float)exp2(-(double)jj * (1.0 / 16.0) * 18.931568569324174); sincos_d((float)pos * inv, sn, cs); ropeB[pos * 32 + jj] = cs; ropeB[pos * 32 + 16 + jj] = sn; }
        }
        for (int m = gw; m < T; m += NGW) {
            const f32x4* xr = (const f32x4*)(x_in + (size_t)m * D) + lane; f32x4 v[4]; float s = 0.f;
#pragma unroll
            for (int j = 0; j < 4; ++j) { v[j] = xr[64 * j]; s += (v[j].x * v[j].x + v[j].y * v[j].y) + (v[j].z * v[j].z + v[j].w * v[j].w); }
            s = wave_sum(s); if (lane == 0) ssq[m] = (pg8::ssq_t)(unsigned)(s * 65536.0f + 0.5f);
            unsigned long long* o8 = (unsigned long long*)(XB + (size_t)m * D) + lane;
#pragma unroll
            for (int j = 0; j < 4; ++j) o8[64 * j] = (unsigned long long)pk2(v[j].x, v[j].y) | ((unsigned long long)pk2(v[j].z, v[j].w) << 32);
        }
    }
    if (P.ws == nullptr) grid.sync();
    GSYNC();
    bool local_ok = (G == 256);
    { unsigned* bw = (unsigned*)(P.ws + WS_BAR);
#pragma unroll
      for (int j2 = 0; j2 < 8; ++j2) local_ok = local_ok && (xb_ld(&bw[XB_XCNT(j2)]) == 32u); }
    local_ok = __builtin_amdgcn_readfirstlane((int)local_ok) != 0;
    const int xrank = __builtin_amdgcn_readfirstlane((int)((volatile LAS unsigned*)(lds + 131072))[2]), xcc = (int)xbar.x;
    const int cgemm = local_ok ? xrank * 8 + xcc : bx;
    const int vcu = local_ok ? xcc * 32 + xrank : vcu0;
#define LSYNC() do { XcdBarrier b_ = xbar; asm volatile("" : "+s"(b_.bar), "+s"(b_.x)); if (local_ok) xcd_local_barrier(b_); else xcd_barrier(b_); } while (0)

    const float QS64 = 0.125f * fa::LOG2E, QS96 = 0.10206207261596577f * fa::LOG2E;
#ifndef NO_GEMM
#define GEMM_CALL(EPI, e_) if constexpr (En<EPI>::v) pg8::gemm_phase<EPI, pg8::StaticOrder, true, true>(lds, g_, S_, e_);
#else
#define GEMM_CALL(EPI, e_) (void)e_;
#endif
#define GEMM_PHASE(EPI, e_, A_, B_, N_, K_, lda_, ldb_) do { const pg8::bf16_t* pa_ = (const pg8::bf16_t*)(A_); const pg8::bf16_t* pb_ = (const pg8::bf16_t*)(B_); int c_ = cgemm; asm volatile("" : "+s"(pa_), "+s"(pb_), "+s"(c_)); \
        pg8::Gemm g_{pa_, pb_, T, (N_), (K_), (lda_), (ldb_)}; pg8::StaticOrder S_; S_.init(T, (N_), G, c_); \
        GEMM_CALL(EPI, e_) } while (0)

#pragma unroll 1
    for (int layer = 0; layer < 4; ++layer) {
        const int mix = layer % 3, j = layer / 3;
        const float* x_old = layer == 0 ? x_in : out;
        pg8::ssq_t* ssq_attn = ssq + (size_t)(2 * layer) * T; pg8::ssq_t* ssq_ffn = ssq + (size_t)(2 * layer + 1) * T; pg8::ssq_t* ssq_next = ssq + (size_t)(2 * layer + 2) * T;
        const bf16* wo_t;
        if (mix == 0) {
            { pg8::EpiQKV E{QKV, ssq_attn, ropeA, QS64}; GEMM_PHASE(pg8::EpiQKV, E, XB, ws + W_AQKV + (size_t)j * 3072 * 1024 * 2, 3072, 1024, 1024, 1024); }
#ifdef PROBE_QKV2
            { pg8::EpiQKV E{QKV, ssq_attn, ropeA, QS64}; GEMM_PHASE(pg8::EpiQKV, E, XB, ws + W_AQKV + (size_t)j * 3072 * 1024 * 2, 3072, 1024, 1024, 1024); }
#endif
            LSYNC();
            {
                const float* lq1 = P.in[5] + j * 64; const float* lk1 = P.in[6] + j * 64; const float* lq2 = P.in[7] + j * 64; const float* lk2 = P.in[8] + j * 64;
                float s1 = 0.f, s2 = 0.f;
                for (int i = 0; i < 64; ++i) { s1 += lq1[i] * lk1[i]; s2 += lq2[i] * lk2[i]; }
                const float lam_init = 0.8f - 0.6f * expf(-0.3f * (float)layer);
                const float lam = expf(s1) - expf(s2) + lam_init;
                const int total = 8 * 8 * 16, per = (total + G - 1) / G;
                for (int i = 0; i < per; ++i) { const int uid = vcu * per + i; if (uid >= total) break; const int bh = uid >> 4, qb = uid & 15;

#ifndef NO_DIFF
 fa::diff_unit((FA_LAS char*)lds, QKV, OB, bh >> 3, bh & 7, qb, lam, 1.0f - lam_init, P.in[9] + j * 128);
#ifdef PROBE_DIFF2
 fa::diff_unit((FA_LAS char*)lds, QKV, OB, bh >> 3, bh & 7, qb, lam, 1.0f - lam_init, P.in[9] + j * 128);
#endif
#endif
 }
            }
            wo_t = (const bf16*)(ws + W_AWO + (size_t)j * 1024 * 1024 * 2);
        } else if (mix == 1) {
            pg8::ssq_t* ssq_q = ssq + (size_t)9 * T; pg8::ssq_t* ssq_kv = ssq + (size_t)10 * T;
            { pg8::EpiMlaA E{ARAW, MKR, ssq_attn, ssq_q, ssq_kv, ropeB}; GEMM_PHASE(pg8::EpiMlaA, E, XB, ws + W_BWA, 768, 1024, 1024, 1024); }
            LSYNC();
            { pg8::EpiMlaQ E{MQ, ssq_q, ropeB, QS96}; GEMM_PHASE(pg8::EpiMlaQ, E, ARAW, ws + W_BQB, 1536, 384, 768, 384); }
            { pg8::EpiScale E{MKV, 2048, ssq_kv, 1.0f / 256.0f}; GEMM_PHASE(pg8::EpiScale, E, ARAW + 384, ws + W_BKVB, 2048, 256, 768, 256); }
            GSYNC();
            {
                const int total = 8 * 16 * 16, per = (total + G - 1) / G;
                for (int i = 0; i < per; ++i) { const int uid = vcu * per + i; if (uid >= total) break; const int bh = uid >> 4, qb = uid & 15;

#ifndef NO_MLA
 fa::mla_unit((FA_LAS char*)lds, MQ, MKV, MKR, OB, bh >> 4, bh & 15, qb);
#ifdef PROBE_MLA2
 fa::mla_unit((FA_LAS char*)lds, MQ, MKV, MKR, OB, bh >> 4, bh & 15, qb);
#endif
#endif
 }
            }
            wo_t = (const bf16*)(ws + W_BWO);
        } else {
#pragma unroll 1
            for (int g = 0; g < 3; ++g) {
                const int dil = g == 0 ? 1 : (g == 1 ? 4 : 16);
                { pg8::EpiQKV E{QKV, ssq_attn, ropeA, QS64}; GEMM_PHASE(pg8::EpiQKV, E, XB, ws + W_CQKV + (size_t)g * 3072 * 1024 * 2, 3072, 1024, 1024, 1024); }
#ifdef PROBE_QKV2
                { pg8::EpiQKV E{QKV, ssq_attn, ropeA, QS64}; GEMM_PHASE(pg8::EpiQKV, E, XB, ws + W_CQKV + (size_t)g * 3072 * 1024 * 2, 3072, 1024, 1024, 1024); }
#endif
                LSYNC();
                {
                    const int total = 8 * 8 * 32, per = (total + G - 1) / G, nq = 32 / dil;
                    for (int i = 0; i < per; ++i) { const int uid = vcu * per + i; if (uid >= total) break; const int bh = uid >> 5, sub = uid & 31;
#ifndef NO_DIL
                        fa::dil2_unit((FA_LAS char*)lds, QKV, OB, LSE, bh >> 3, bh & 7, dil, sub / nq, (sub % nq) * 128, g == 0);
#endif
                    }
                }
                if (g < 2) LSYNC();
            }
            wo_t = (const bf16*)(ws + W_CWO);
        }
        LSYNC();
        { pg8::EpiRes E{layer == 0 ? x_in : nullptr, nullptr, XB, 1, ssq_ffn}; GEMM_PHASE(pg8::EpiRes, E, OB, wo_t, 1024, 1024, 1024, 1024); }
        GSYNC();
        { pg8::EpiSwiGLU E{ACT, ssq_ffn}; GEMM_PHASE(pg8::EpiSwiGLU, E, XB, ws + W_GU + (size_t)layer * 5632 * 1024 * 2, 5632, 1024, 1024, 1024); }
#ifdef PROBE_GU2
        { pg8::EpiSwiGLU E{ACT, ssq_ffn}; GEMM_PHASE(pg8::EpiSwiGLU, E, XB, ws + W_GU + (size_t)layer * 5632 * 1024 * 2, 5632, 1024, 1024, 1024); }
#endif
        LSYNC();
        { pg8::EpiRes E{nullptr, layer < 3 ? nullptr : out, XB, layer < 3 ? 1 : 0, ssq_next}; GEMM_PHASE(pg8::EpiRes, E, ACT, ws + W_OUT + (size_t)layer * 1024 * 2816 * 2, 1024, 2816, 2816, 2816); }
        if (layer < 3) GSYNC(); else LSYNC();
    }
    {
        int tid2 = threadIdx.x; asm volatile("" : "+v"(tid2)); const int lane = tid2 & 63, wave = __builtin_amdgcn_readfirstlane(tid2 >> 6);
        const pg8::ssq_t* sf = ssq + (size_t)8 * T;
        const int m0 = local_ok ? xcc * 4096 + xrank * NWAVES + wave : vcu * NWAVES + wave, mstep = local_ok ? 256 : G * NWAVES, mend = local_ok ? (xcc + 1) * 4096 : T;
        for (int m = m0; m < mend; m += mstep) {
            const float rinv = __builtin_amdgcn_rsqf(pg8::ssq_get(sf, m) * (1.0f / 1024.0f) + 1e-6f);
            f32x4* xr = (f32x4*)(out + (size_t)m * D) + lane; const f32x4* gn = (const f32x4*)final_norm + lane;
#pragma unroll
            for (int jj = 0; jj < 4; ++jj) { const f32x4 v = xr[64 * jj]; xr[64 * jj] = v * rinv * gn[64 * jj]; }
        }
    }
}

extern "C" void kernel_launch(void* const* d_in, const int* in_sizes, int n_in, void* d_out, int out_size, void* d_ws, size_t ws_size, hipStream_t stream) {
    static int grid = 0;
    if (grid == 0) {
        if (n_in != 21 || in_sizes[0] != T * D || out_size != T * D || ws_size < WS_END) { fprintf(stderr, "kernel_launch: unexpected shapes (n_in %d, ws %zu); nothing launched\n", n_in, ws_size); grid = -1; return; }
        int dev = 0, cus = 0, per_cu = 0;
        hipGetDevice(&dev); hipDeviceGetAttribute(&cus, hipDeviceAttributeMultiprocessorCount, dev);
        if (hipFuncSetAttribute((const void*)fwd_kernel, hipFuncAttributeMaxDynamicSharedMemorySize, LDS_BYTES) != hipSuccess) { fprintf(stderr, "kernel_launch: hipFuncSetAttribute failed\n"); grid = -1; return; }
        if (hipOccupancyMaxActiveBlocksPerMultiprocessor(&per_cu, (const void*)fwd_kernel, NWAVES * 64, LDS_BYTES) != hipSuccess || per_cu < 1) { fprintf(stderr, "kernel_launch: occupancy query gave %d\n", per_cu); per_cu = 1; }
        (void)hipGetLastError();
        grid = cus * per_cu;
    }
    if (grid < 0) return;
    hipMemsetAsync((char*)d_ws + WS_SSQ2, 0, SSQ2_BYTES + 16384, stream);
    Params p{};
    for (int i = 0; i < 21; ++i) p.in[i] = (const float*)d_in[i];
    p.out = (float*)d_out; p.ws = (unsigned char*)d_ws;
    void* args[] = {&p};
    hipError_t e = hipLaunchCooperativeKernel((const void*)fwd_kernel, dim3(grid), dim3(NWAVES * 64), args, LDS_BYTES, stream);
    if (e != hipSuccess) fprintf(stderr, "cooperative launch failed: %s (grid %d)\n", hipGetErrorString(e), grid);
}
```

```cpp
#include <hip/hip_runtime.h>
#include <hip/hip_cooperative_groups.h>
#include <cstdio>
#include <cstdint>
namespace cg = cooperative_groups;
namespace pg8 {
#define PG8_LAS __attribute__((address_space(3)))
typedef unsigned short bf16_t;
typedef short bf16x8 __attribute__((ext_vector_type(8)));
typedef float f32x4 __attribute__((ext_vector_type(4)));
typedef unsigned u32x4 __attribute__((ext_vector_type(4)));
constexpr int BM = 256, BK = 64, HALF = 128, HTB = HALF * BK * 2  , STAGE_BYTES = 8 * HTB, NXCD = 8, WGM = 8;

__host__ __device__ __forceinline__ int lds_byte(int r, int c) { const int st = (r >> 4) * 2 + (c >> 5), rr = r & 15, cc = c & 31, ob = rr * 64 + cc * 2; return st * 1024 + (ob ^ (((ob >> 9) & 1) << 5)); }
__host__ __device__ __forceinline__ void stage_rc(int b, int& R, int& C) { const int st = b / 1024, sb = b % 1024, swz = sb ^ (((sb >> 9) & 1) << 5); R = (st >> 1) * 16 + swz / 64; C = (st & 1) * 32 + (swz % 64) / 2; }
__host__ __device__ __forceinline__ int perm32(int rho) { const int n = rho >> 4, i = rho & 15; return 8 * (i >> 2) + 4 * n + (i & 3); }

struct Unit { int pm, pn; };
struct Gemm { const bf16_t* A; const bf16_t* Bt; int M, N, K, lda, ldb; };

struct StaticOrder {
    int nM, nN, nwg, G, c;
    __host__ __device__ void init(int M, int N, int G_, int c_) { nM = M / BM; nN = N / BM; nwg = nM * nN; G = G_; c = c_; }
    __host__ __device__ bool next(int i, Unit& u) const {
        const long L = (long)i * G + c; if (L >= nwg) return false;
        int wgid = (int)L; { const int q = nwg / NXCD, r = nwg % NXCD, xcd = wgid % NXCD, off = wgid / NXCD; wgid = (xcd < r ? xcd * (q + 1) : r * (q + 1) + (xcd - r) * q) + off; }
        const int nig = WGM * nN, gid = wgid / nig, fm = gid * WGM, gsz = (nM - fm) < WGM ? (nM - fm) : WGM;
        u.pm = fm + ((wgid % nig) % gsz); u.pn = (wgid % nig) / gsz; return true;
    }
    __device__ __forceinline__ void a_ready(const Unit&) const {}
    __device__ __forceinline__ void done(const Unit&) const {}
};

typedef float f32x2 __attribute__((ext_vector_type(2)));
typedef __bf16 bf16x2_t __attribute__((ext_vector_type(2)));
__device__ __forceinline__ unsigned cvt_pk_bf16(float lo, float hi) { f32x2 v = {lo, hi}; bf16x2_t b = __builtin_convertvector(v, bf16x2_t); return __builtin_bit_cast(unsigned, b); }
__device__ __forceinline__ u32x4 pack8(const f32x4 v0, const f32x4 v1) { u32x4 w; w.x = cvt_pk_bf16(v0[0], v0[1]); w.y = cvt_pk_bf16(v0[2], v0[3]); w.z = cvt_pk_bf16(v1[0], v1[1]); w.w = cvt_pk_bf16(v1[2], v1[3]); return w; }
__device__ __forceinline__ f32x4 shx4(const f32x4 v, int mask) { f32x4 r; r[0] = __shfl_xor(v[0], mask); r[1] = __shfl_xor(v[1], mask); r[2] = __shfl_xor(v[2], mask); r[3] = __shfl_xor(v[3], mask); return r; }
__device__ __forceinline__ float xlane16(float v, int fq) { auto rr = __builtin_amdgcn_permlane16_swap(__float_as_uint(v), __float_as_uint(v), false, false); return __uint_as_float((fq & 1) ? rr[0] : rr[1]); }
__device__ __forceinline__ float xlane32(float v, int fq) { auto rr = __builtin_amdgcn_permlane32_swap(__float_as_uint(v), __float_as_uint(v), false, false); return __uint_as_float((fq & 2) ? rr[0] : rr[1]); }
__device__ __forceinline__ f32x4 swp16x4(const f32x4 v, int fq) { f32x4 r; r[0] = xlane16(v[0], fq); r[1] = xlane16(v[1], fq); r[2] = xlane16(v[2], fq); r[3] = xlane16(v[3], fq); return r; }
__device__ __forceinline__ f32x4 swp32x4(const f32x4 v, int fq) { f32x4 r; r[0] = xlane32(v[0], fq); r[1] = xlane32(v[1], fq); r[2] = xlane32(v[2], fq); r[3] = xlane32(v[3], fq); return r; }
constexpr float RMS_EPS = 1e-6f;
typedef unsigned long long ssq_t;
__device__ __forceinline__ float ssq_get(const ssq_t* p, int row) { return (float)p[row] * (1.0f / 65536.0f); }
__device__ __forceinline__ void ssq_add(ssq_t* p, int row, float part) { (void)__hip_atomic_fetch_add(p + row, (ssq_t)(unsigned)(part * 65536.0f + 0.5f), __ATOMIC_RELAXED, __HIP_MEMORY_SCOPE_AGENT); }

struct EpiQKV {
    static constexpr bool PERM = true, AFTER_DRAIN = false;
    bf16_t* O; const ssq_t* ssq; const float* rope; float qscale;
    __device__ __forceinline__ void operator()(const f32x4 (&acc)[2][2][4][2], const Unit& u, int wr, int wc, int fr, int fq) const {
        const int cls = u.pn >> 2; const float sc = cls == 0 ? qscale : 1.f;
        const bool do_rope = (cls < 2) && ((wc & 1) == 0);
#pragma unroll
        for (int ai = 0; ai < 2; ++ai)
#pragma unroll
            for (int m = 0; m < 4; ++m) {
                const int row = u.pm * BM + ai * HALF + wr * 64 + m * 16 + fr;
                const float rinv = __builtin_amdgcn_rsqf(ssq_get(ssq, row) * (1.0f / 1024.0f) + RMS_EPS) * sc;
                f32x4 c0, c1, s0, s1;
                if (do_rope) { const f32x4* tb = (const f32x4*)(rope + (size_t)(row & 4095) * 16); c0 = tb[0]; c1 = tb[1]; s0 = tb[2]; s1 = tb[3]; if (fq == 0) { s0 = -s0; s1 = -s1; } }
#pragma unroll
                for (int bj = 0; bj < 2; ++bj) {
                    f32x4 v0 = acc[ai][bj][m][0] * rinv, v1 = acc[ai][bj][m][1] * rinv;
                    if (do_rope) { const f32x4 p0 = swp16x4(v0, fq), p1 = swp16x4(v1, fq); if (fq < 2) { v0 = v0 * c0 + p0 * s0; v1 = v1 * c1 + p1 * s1; } }
                    *(u32x4*)(O + (size_t)row * 3072 + u.pn * BM + bj * HALF + wc * 32 + 8 * fq) = pack8(v0, v1);
                }
                asm volatile("" ::: "memory");
            }
    }
};
struct EpiScale {
    static constexpr bool PERM = true, AFTER_DRAIN = false;
    bf16_t* O; int ldc; const ssq_t* ssq; float inv_n;
    __device__ __forceinline__ void operator()(const f32x4 (&acc)[2][2][4][2], const Unit& u, int wr, int wc, int fr, int fq) const {
#pragma unroll
        for (int ai = 0; ai < 2; ++ai)
#pragma unroll
            for (int m = 0; m < 4; ++m) {
                const int row = u.pm * BM + ai * HALF + wr * 64 + m * 16 + fr;
                const float rinv = __builtin_amdgcn_rsqf(ssq_get(ssq, row) * inv_n + RMS_EPS);
#pragma unroll
                for (int bj = 0; bj < 2; ++bj)
                    *(u32x4*)(O + (size_t)row * ldc + u.pn * BM + bj * HALF + wc * 32 + 8 * fq) = pack8(acc[ai][bj][m][0] * rinv, acc[ai][bj][m][1] * rinv);
                asm volatile("" ::: "memory");
            }
    }
};
struct EpiMlaQ {
    static constexpr bool PERM = true, AFTER_DRAIN = false;
    bf16_t* O; const ssq_t* ssq; const float* rope; float qscale;
    __device__ __forceinline__ void operator()(const f32x4 (&acc)[2][2][4][2], const Unit& u, int wr, int wc, int fr, int fq) const {
#pragma unroll
        for (int ai = 0; ai < 2; ++ai)
#pragma unroll
            for (int m = 0; m < 4; ++m) {
                const int row = u.pm * BM + ai * HALF + wr * 64 + m * 16 + fr;
                const float rinv = __builtin_amdgcn_rsqf(ssq_get(ssq, row) * (1.0f / 384.0f) + RMS_EPS) * qscale;
#pragma unroll
                for (int bj = 0; bj < 2; ++bj) {
                    const int grp = u.pn * 8 + bj * 4 + wc;
                    f32x4 v0 = acc[ai][bj][m][0] * rinv, v1 = acc[ai][bj][m][1] * rinv;
                    if (grp % 3 == 2) {
                        const f32x4 p0 = swp32x4(v0, fq), p1 = swp32x4(v1, fq);
                        const f32x4* tb = (const f32x4*)(rope + (size_t)(row & 4095) * 32 + 8 * (fq & 1));
                        const f32x4 c0 = tb[0], c1 = tb[1]; f32x4 s0 = tb[4], s1 = tb[5]; if (fq < 2) { s0 = -s0; s1 = -s1; }
                        v0 = v0 * c0 + p0 * s0; v1 = v1 * c1 + p1 * s1;
                    }
                    *(u32x4*)(O + (size_t)row * 1536 + u.pn * BM + bj * HALF + wc * 32 + 8 * fq) = pack8(v0, v1);
                }
                asm volatile("" ::: "memory");
            }
    }
};
struct EpiMlaA {
    static constexpr bool PERM = true, AFTER_DRAIN = false;
    bf16_t* O; bf16_t* KR; const ssq_t* ssq; ssq_t* ssq_q; ssq_t* ssq_kv; const float* rope;
    __device__ __forceinline__ void operator()(const f32x4 (&acc)[2][2][4][2], const Unit& u, int wr, int wc, int fr, int fq) const {
#pragma unroll
        for (int ai = 0; ai < 2; ++ai)
#pragma unroll
            for (int m = 0; m < 4; ++m) {
                const int row = u.pm * BM + ai * HALF + wr * 64 + m * 16 + fr;
                const float rinv = __builtin_amdgcn_rsqf(ssq_get(ssq, row) * (1.0f / 1024.0f) + RMS_EPS);
#pragma unroll
                for (int bj = 0; bj < 2; ++bj) {
                    const int cg = u.pn * BM + bj * HALF + wc * 32;
                    f32x4 v0 = acc[ai][bj][m][0] * rinv, v1 = acc[ai][bj][m][1] * rinv;
                    if (cg < 640) {
                        *(u32x4*)(O + (size_t)row * 768 + cg + 8 * fq) = pack8(v0, v1);
                        float part = (v0[0] * v0[0] + v0[1] * v0[1]) + (v0[2] * v0[2] + v0[3] * v0[3]) + (v1[0] * v1[0] + v1[1] * v1[1]) + (v1[2] * v1[2] + v1[3] * v1[3]);
                        part += __shfl_xor(part, 16); part += __shfl_xor(part, 32);
                        if (fq == 0) ssq_add(cg < 384 ? ssq_q : ssq_kv, row, part);
                    } else if (cg == 640) {
                        const f32x4 p0 = swp32x4(v0, fq), p1 = swp32x4(v1, fq);
                        const f32x4* tb = (const f32x4*)(rope + (size_t)(row & 4095) * 32 + 8 * (fq & 1));
                        const f32x4 c0 = tb[0], c1 = tb[1]; f32x4 s0 = tb[4], s1 = tb[5]; if (fq < 2) { s0 = -s0; s1 = -s1; }
                        v0 = v0 * c0 + p0 * s0; v1 = v1 * c1 + p1 * s1;
                        *(u32x4*)(KR + (size_t)row * 32 + 8 * fq) = pack8(v0, v1);
                    }
                }
                asm volatile("" ::: "memory");
            }
    }
};
struct EpiRes {
    static constexpr bool PERM = true, AFTER_DRAIN = false;
    const float* xin32; float* xout32; bf16_t* xb; int wr_b16; ssq_t* ssq_out;
    __device__ __forceinline__ void operator()(const f32x4 (&acc)[2][2][4][2], const Unit& u, int wr, int wc, int fr, int fq) const {
#pragma unroll
        for (int ai = 0; ai < 2; ++ai)
#pragma unroll
            for (int m = 0; m < 4; ++m) {
                const int row = u.pm * BM + ai * HALF + wr * 64 + m * 16 + fr;
                float part = 0.f;
#pragma unroll
                for (int bj = 0; bj < 2; ++bj) {
                    const size_t off = (size_t)row * 1024 + u.pn * BM + bj * HALF + wc * 32 + 8 * fq;
                    f32x4 a0, a1;
                    if (xin32) { a0 = *(const f32x4*)(xin32 + off); a1 = *(const f32x4*)(xin32 + off + 4); }
                    else { const u32x4 w = *(const u32x4*)(xb + off);
                        a0 = (f32x4){__uint_as_float(w.x << 16), __uint_as_float(w.x & 0xffff0000u), __uint_as_float(w.y << 16), __uint_as_float(w.y & 0xffff0000u)};
                        a1 = (f32x4){__uint_as_float(w.z << 16), __uint_as_float(w.z & 0xffff0000u), __uint_as_float(w.w << 16), __uint_as_float(w.w & 0xffff0000u)}; }
                    const f32x4 v0 = a0 + acc[ai][bj][m][0], v1 = a1 + acc[ai][bj][m][1];
                    if (xout32) { *(f32x4*)(xout32 + off) = v0; *(f32x4*)(xout32 + off + 4) = v1; }
                    if (wr_b16) *(u32x4*)(xb + off) = pack8(v0, v1);
                    part += (v0[0] * v0[0] + v0[1] * v0[1]) + (v0[2] * v0[2] + v0[3] * v0[3]) + (v1[0] * v1[0] + v1[1] * v1[1]) + (v1[2] * v1[2] + v1[3] * v1[3]);
                }
                part += __shfl_xor(part, 16); part += __shfl_xor(part, 32);
                if (fq == 0) ssq_add(ssq_out, row, part);
                asm volatile("" ::: "memory");
            }
    }
};
struct EpiSwiGLU {
    static constexpr bool PERM = true, AFTER_DRAIN = false;
    bf16_t* O; const ssq_t* ssq;
    __device__ __forceinline__ void operator()(const f32x4 (&acc)[2][2][4][2], const Unit& u, int wr, int wc, int fr, int fq) const {
#pragma unroll
        for (int ai = 0; ai < 2; ++ai)
#pragma unroll
            for (int m = 0; m < 4; ++m) {
                const int row = u.pm * BM + ai * HALF + wr * 64 + m * 16 + fr;
                const float rinv = __builtin_amdgcn_rsqf(ssq_get(ssq, row) * (1.0f / 1024.0f) + RMS_EPS);
                f32x4 r[2];
#pragma unroll
                for (int n = 0; n < 2; ++n) {
                    const f32x4 g = acc[ai][0][m][n] * rinv, uu = acc[ai][1][m][n] * rinv;
#pragma unroll
                    for (int e = 0; e < 4; ++e) { const float sg = __builtin_amdgcn_rcpf(1.0f + __builtin_amdgcn_exp2f(g[e] * -1.4426950408889634f)); r[n][e] = g[e] * sg * uu[e]; }
                }
                *(u32x4*)(O + (size_t)row * 2816 + u.pn * HALF + wc * 32 + 8 * fq) = pack8(r[0], r[1]);
                asm volatile("" ::: "memory");
            }
    }
};
template <class Epi, class Sched, bool ALIGN_EPI = false, bool SP2 = false>
__device__ __forceinline__ void gemm_phase(PG8_LAS unsigned char* lds, const Gemm g, const Sched& S, const Epi& E) {
    int tid_ = threadIdx.x; asm volatile("" : "+v"(tid_));
    const int tid = tid_, wid = __builtin_amdgcn_readfirstlane(tid >> 6), lane = tid & 63, wr = wid >> 2, wc = wid & 3, fr = lane & 15, fq = lane >> 4;
    const int K = g.K, nt = K / BK;
    unsigned voffA[2], voffB[2];
#pragma unroll
    for (int i = 0; i < 2; ++i) { int R, C; stage_rc(tid * 16 + i * 8192, R, C); const int Rb = Epi::PERM ? ((R & ~31) + perm32(R & 31)) : R;
        voffA[i] = (unsigned)(R * g.lda + C) * 2u; voffB[i] = (unsigned)(Rb * g.ldb + C) * 2u; }
    const size_t kstep = (size_t)(BK * 2);
    const size_t hstepA = (size_t)HALF * g.lda * 2, hstepB = (size_t)HALF * g.ldb * 2;
    const size_t tstepA = 2 * hstepA, tstepB = 2 * hstepB;
    const unsigned ldsw = (unsigned)wid * 1024u;
    const int aoff = lds_byte(wr * 64 + fr, fq * 8), boff = lds_byte(wc * 32 + fr, fq * 8);
#define PG8_SA(b, h) (((b) * 2 + (h)) * HTB)
#define PG8_SB(b, h) ((4 + (b) * 2 + (h)) * HTB)
#define PG8_STAGE(bufoff, gbase, voff) do { _Pragma("unroll") for (int _i = 0; _i < 2; ++_i) \
        __builtin_amdgcn_global_load_lds((const unsigned*)((const char*)(gbase) + (voff)[_i]), (PG8_LAS unsigned*)(lds + (bufoff) + ldsw + _i * 8192), 16, 0, 0); } while (0)
#define PG8_LDA(dst, b, h) do { _Pragma("unroll") for (int m = 0; m < 4; ++m) _Pragma("unroll") for (int k = 0; k < 2; ++k) dst[m][k] = *(const PG8_LAS bf16x8*)(lds + PG8_SA(b, h) + aoff + m * 2048 + k * 1024); } while (0)
#define PG8_LDB(dst, b, h) do { _Pragma("unroll") for (int n = 0; n < 2; ++n) _Pragma("unroll") for (int k = 0; k < 2; ++k) dst[n][k] = *(const PG8_LAS bf16x8*)(lds + PG8_SB(b, h) + boff + n * 2048 + k * 1024); } while (0)
#define PG8_MMA(ai, bj, At, Bt) do { __builtin_amdgcn_s_setprio(1); _Pragma("unroll") for (int m = 0; m < 4; ++m) _Pragma("unroll") for (int n = 0; n < 2; ++n) _Pragma("unroll") for (int k = 0; k < 2; ++k) \
        acc[ai][bj][m][n] = __builtin_amdgcn_mfma_f32_16x16x32_bf16(Bt[n][k], At[m][k], acc[ai][bj][m][n], 0, 0, 0); __builtin_amdgcn_s_setprio(0); } while (0)
#define PG8_WAIT_V(n) asm volatile("s_waitcnt vmcnt(" #n ")" ::: "memory")
#define PG8_WAIT_L(n) asm volatile("s_waitcnt lgkmcnt(" #n ")" ::: "memory")
#define PG8_BAR __builtin_amdgcn_s_barrier()
#define PG8_SCHED __builtin_amdgcn_sched_barrier(0)
    Unit cur, nxt; int ui = 0;
    if (!S.next(0, cur)) return;
    f32x4 acc[2][2][4][2];
#pragma unroll
    for (int a = 0; a < 2; ++a)
#pragma unroll
        for (int b = 0; b < 2; ++b)
#pragma unroll
            for (int m = 0; m < 4; ++m)
#pragma unroll
                for (int n = 0; n < 2; ++n) acc[a][b][m][n] = (f32x4){0.f, 0.f, 0.f, 0.f};
    bf16x8 At[4][2], B0[2][2], B1[2][2];
    const char* cA = (const char*)g.A + (size_t)cur.pm * tstepA; const char* cB = (const char*)g.Bt + (size_t)cur.pn * tstepB;
    S.a_ready(cur);
    if constexpr (SP2) {
        PG8_STAGE(PG8_SB(0, 0), cB, voffB); PG8_STAGE(PG8_SB(0, 1), cB + hstepB, voffB); PG8_STAGE(PG8_SA(0, 0), cA, voffA); PG8_STAGE(PG8_SA(0, 1), cA + hstepA, voffA);
        if (wr == 1) PG8_BAR;
        PG8_WAIT_V(2); PG8_BAR;
        PG8_STAGE(PG8_SB(1, 0), cB + kstep, voffB); PG8_STAGE(PG8_SA(1, 0), cA + kstep, voffA); PG8_STAGE(PG8_SB(1, 1), cB + hstepB + kstep, voffB);
        PG8_WAIT_V(6); PG8_BAR;
    } else {
        PG8_STAGE(PG8_SB(0, 0), cB, voffB); PG8_STAGE(PG8_SA(0, 0), cA, voffA); PG8_STAGE(PG8_SB(0, 1), cB + hstepB, voffB); PG8_STAGE(PG8_SA(0, 1), cA + hstepA, voffA);
        if (wr == 1) PG8_BAR;
        PG8_WAIT_V(4); PG8_BAR;
        PG8_STAGE(PG8_SB(1, 0), cB + kstep, voffB); PG8_STAGE(PG8_SA(1, 0), cA + kstep, voffA); PG8_STAGE(PG8_SB(1, 1), cB + hstepB + kstep, voffB);
        PG8_WAIT_V(6); PG8_BAR;
    }
    for (;;) {
        const bool has_next = S.next(ui + 1, nxt);
        const char* nA = has_next ? (const char*)g.A + (size_t)nxt.pm * tstepA : cA; const char* nB = has_next ? (const char*)g.Bt + (size_t)nxt.pn * tstepB : cB;
#pragma unroll 1
        for (int t = 0; t < nt; t += 2) {
            const bool last = (t == nt - 2);
            const char* a1 = cA + (size_t)(t + 1) * kstep;
            const char* a2 = last ? nA : cA + (size_t)(t + 2) * kstep; const char* b2 = last ? nB : cB + (size_t)(t + 2) * kstep;
            const char* a3 = a2 + kstep; const char* b3 = b2 + kstep;
            if (last && has_next) S.a_ready(nxt);
            if constexpr (SP2) {
            PG8_LDB(B0, 0, 0); PG8_LDB(B1, 0, 1); PG8_SCHED; PG8_LDA(At, 0, 0); PG8_STAGE(PG8_SA(1, 1), a1 + hstepA, voffA);
            PG8_WAIT_V(8); PG8_WAIT_L(0); PG8_BAR; PG8_MMA(0, 0, At, B0); PG8_MMA(0, 1, At, B1); PG8_BAR; PG8_SCHED;
            PG8_LDA(At, 0, 1); PG8_STAGE(PG8_SB(0, 0), b2, voffB); PG8_STAGE(PG8_SB(0, 1), b2 + hstepB, voffB); PG8_STAGE(PG8_SA(0, 0), a2, voffA);
            PG8_WAIT_V(8); PG8_WAIT_L(0); PG8_BAR; PG8_MMA(1, 0, At, B0); PG8_MMA(1, 1, At, B1); PG8_BAR; PG8_SCHED;
            PG8_LDB(B0, 1, 0); PG8_LDB(B1, 1, 1); PG8_SCHED; PG8_LDA(At, 1, 0); PG8_STAGE(PG8_SA(0, 1), a2 + hstepA, voffA);
            PG8_WAIT_V(8); PG8_WAIT_L(0); PG8_BAR; PG8_MMA(0, 0, At, B0); PG8_MMA(0, 1, At, B1); PG8_BAR; PG8_SCHED;
            PG8_LDA(At, 1, 1); PG8_STAGE(PG8_SB(1, 0), b3, voffB); PG8_STAGE(PG8_SB(1, 1), b3 + hstepB, voffB); PG8_STAGE(PG8_SA(1, 0), a3, voffA);
            PG8_WAIT_V(8); PG8_WAIT_L(0); PG8_BAR; PG8_MMA(1, 0, At, B0); PG8_MMA(1, 1, At, B1); PG8_BAR; PG8_SCHED;
            } else {
            PG8_LDB(B0, 0, 0); PG8_SCHED; PG8_LDA(At, 0, 0); PG8_STAGE(PG8_SA(1, 1), a1 + hstepA, voffA);
            PG8_WAIT_L(8); PG8_BAR; PG8_WAIT_L(0); PG8_MMA(0, 0, At, B0); PG8_BAR; PG8_SCHED;
            PG8_LDB(B1, 0, 1); PG8_STAGE(PG8_SB(0, 0), b2, voffB);
            PG8_BAR; PG8_WAIT_L(0); PG8_MMA(0, 1, At, B1); PG8_BAR;
            PG8_LDA(At, 0, 1); PG8_STAGE(PG8_SA(0, 0), a2, voffA);
            PG8_BAR; PG8_WAIT_L(0); PG8_MMA(1, 0, At, B0); PG8_BAR; PG8_SCHED;
            PG8_STAGE(PG8_SB(0, 1), b2 + hstepB, voffB);
            PG8_WAIT_V(6); PG8_BAR; PG8_MMA(1, 1, At, B1); PG8_BAR;
            PG8_LDB(B0, 1, 0); PG8_SCHED; PG8_LDA(At, 1, 0); PG8_STAGE(PG8_SA(0, 1), a2 + hstepA, voffA);
            PG8_WAIT_L(8); PG8_BAR; PG8_WAIT_L(0); PG8_MMA(0, 0, At, B0); PG8_BAR; PG8_SCHED;
            PG8_LDB(B1, 1, 1); PG8_STAGE(PG8_SB(1, 0), b3, voffB);
            PG8_BAR; PG8_WAIT_L(0); PG8_MMA(0, 1, At, B1); PG8_BAR;
            PG8_LDA(At, 1, 1); PG8_STAGE(PG8_SA(1, 0), a3, voffA);
            PG8_BAR; PG8_WAIT_L(0); PG8_MMA(1, 0, At, B0); PG8_BAR; PG8_SCHED;
            PG8_STAGE(PG8_SB(1, 1), b3 + hstepB, voffB);
            PG8_WAIT_V(6); PG8_BAR; PG8_MMA(1, 1, At, B1); PG8_BAR;
            }
        }
        if constexpr (ALIGN_EPI) { if (wr == 0) PG8_BAR; }
        if constexpr (!Epi::AFTER_DRAIN) { E(acc, cur, wr, wc, fr, fq); S.done(cur); }
        if (!has_next) break;
#pragma unroll
        for (int a = 0; a < 2; ++a)
#pragma unroll
            for (int b = 0; b < 2; ++b)
#pragma unroll
                for (int m = 0; m < 4; ++m)
#pragma unroll
                    for (int n = 0; n < 2; ++n) acc[a][b][m][n] = (f32x4){0.f, 0.f, 0.f, 0.f};
        cur = nxt; cA = nA; cB = nB; ++ui;
        if constexpr (ALIGN_EPI) { if (wr == 1) PG8_BAR; }
    }
    PG8_WAIT_V(0);
    if constexpr (!ALIGN_EPI) { if (wr == 0) PG8_BAR; }
    PG8_BAR;
    if constexpr (Epi::AFTER_DRAIN) { E.fused(acc, cur, wr, wc, fr, fq, lds, wid, lane); S.done(cur); }
#undef PG8_SA
#undef PG8_SB
#undef PG8_STAGE
#undef PG8_LDA
#undef PG8_LDB
#undef PG8_MMA
#undef PG8_WAIT_V
#undef PG8_WAIT_L
#undef PG8_BAR
#undef PG8_SCHED
}
}
namespace fa {
typedef unsigned short bf16_t;
typedef short bf16x8 __attribute__((ext_vector_type(8)));
typedef short s16x4 __attribute__((ext_vector_type(4)));
typedef float f32x4 __attribute__((ext_vector_type(4)));
typedef float f32x16 __attribute__((ext_vector_type(16)));
typedef unsigned u32x4 __attribute__((ext_vector_type(4)));
typedef unsigned u32x2 __attribute__((ext_vector_type(2)));
typedef float f32x2 __attribute__((ext_vector_type(2)));
typedef __bf16 bf16x2_t __attribute__((ext_vector_type(2)));
#define FA_LAS __attribute__((address_space(3)))
__device__ __forceinline__ unsigned cvtpk(float lo, float hi) { f32x2 v = {lo, hi}; bf16x2_t b = __builtin_convertvector(v, bf16x2_t); return __builtin_bit_cast(unsigned, b); }
__device__ __forceinline__ float swap_max(float v) { auto rr = __builtin_amdgcn_permlane32_swap(__float_as_uint(v), __float_as_uint(v), false, false); return __builtin_fmaxf(__uint_as_float(rr[0]), __uint_as_float(rr[1])); }
__device__ __forceinline__ float swap_sum(float v) { auto rr = __builtin_amdgcn_permlane32_swap(__float_as_uint(v), __float_as_uint(v), false, false); return __uint_as_float(rr[0]) + __uint_as_float(rr[1]); }
__device__ __forceinline__ int crow(int r, int hi) { return (r & 3) + 8 * (r >> 2) + 4 * hi; }
__device__ __forceinline__ float bf2f(unsigned short b) { return __uint_as_float((unsigned)b << 16); }

struct Src { const bf16_t* k; size_t kpitch; const bf16_t* k2; size_t k2pitch; const bf16_t* v; size_t vpitch; };
template <int DQK, int DV, int KT = 64> struct Cfg {
    static constexpr int RSK = DQK * 2 + 16, RSV = DV * 2 + 64, KBYTES = KT * RSK, VBYTES = KT * RSV, STAGE = KBYTES + VBYTES, NQ = DQK / 16, NO = DV / 32, NS = KT / 64;
};
template <int DQK, int DV, int KT> struct Regs { u32x4 k[KT / 64], k2, v[(DV / 64) * (KT / 64)]; };

template <int DQK, int DV, int KT> __device__ __forceinline__ void tile_load(const Src& s, int tile, int tid, Regs<DQK, DV, KT>& R) {
    const char* kb_ = (const char*)s.k + (size_t)tile * (2 * KT) * s.kpitch;
    const char* vb_ = (const char*)s.v + (size_t)tile * (2 * KT) * s.vpitch;
#pragma unroll
    for (int i = 0; i < KT / 64; ++i) { const unsigned off = (unsigned)((tid >> 3) + 64 * i) * (unsigned)(s.kpitch * 2) + (unsigned)(tid & 7) * 16u; R.k[i] = *(const u32x4*)(kb_ + off); }
    if constexpr (DQK == 96) { if (KT == 128 || tid < 256) { const char* k2b_ = (const char*)s.k2 + (size_t)tile * (2 * KT) * s.k2pitch; const unsigned off = (unsigned)(tid >> 2) * (unsigned)(s.k2pitch * 2) + (unsigned)(tid & 3) * 16u; R.k2 = *(const u32x4*)(k2b_ + off); } }
    if constexpr (DV == 128) {
#pragma unroll
        for (int i = 0; i < 2 * (KT / 64); ++i) { const unsigned off = (unsigned)((tid >> 4) + 32 * i) * (unsigned)(s.vpitch * 2) + (unsigned)(tid & 15) * 16u; R.v[i] = *(const u32x4*)(vb_ + off); }
    } else {
#pragma unroll
        for (int i = 0; i < KT / 64; ++i) { const unsigned off = (unsigned)((tid >> 3) + 64 * i) * (unsigned)(s.vpitch * 2) + (unsigned)(tid & 7) * 16u; R.v[i] = *(const u32x4*)(vb_ + off); }
    }
}
#define FA_SB() __builtin_amdgcn_sched_barrier(0)
template <int DQK, int DV, bool BAND>
__device__ __forceinline__ void tile_compute(const FA_LAS char* kst, const FA_LAS char* vst, const bf16x8 (&qf)[DQK / 16], f32x16 (&o)[DV / 32], float& m, float& l, f32x16& negm, bool first, int lane, int qidx, int kidx0) {
    using C = Cfg<DQK, DV>;
    const int r32 = lane & 31, h = lane >> 5;
    f32x16 p[2];
    const FA_LAS char* kp = kst + r32 * C::RSK + h * 16;
    const FA_LAS char* vp = vst + (4 * h + ((lane & 15) >> 2)) * C::RSV + (16 * ((lane >> 4) & 1) + 4 * (lane & 3)) * 2;
    {
        bf16x8 kf[C::NQ][2];
#pragma unroll
        for (int dd = 0; dd < C::NQ; ++dd)
#pragma unroll
            for (int kb = 0; kb < 2; ++kb) kf[dd][kb] = *(const FA_LAS bf16x8*)(kp + kb * 32 * C::RSK + dd * 32);
        FA_SB();
        __builtin_amdgcn_s_setprio(1);
#pragma unroll
        for (int dd = 0; dd < C::NQ; ++dd)
#pragma unroll
            for (int kb = 0; kb < 2; ++kb) p[kb] = __builtin_amdgcn_mfma_f32_32x32x16_bf16(kf[dd][kb], qf[dd], dd == 0 ? negm : p[kb], 0, 0, 0);
        __builtin_amdgcn_s_setprio(0);
        FA_SB();
    }
    s16x4 vlo[2][C::NO], vhi[2][C::NO];
#pragma unroll
    for (int db = 0; db < C::NO; ++db) {
        vlo[0][db] = __builtin_bit_cast(s16x4, __builtin_amdgcn_ds_read_tr16_b64_v4i16((FA_LAS s16x4*)(vp + 64 * db)));
        vhi[0][db] = __builtin_bit_cast(s16x4, __builtin_amdgcn_ds_read_tr16_b64_v4i16((FA_LAS s16x4*)(vp + 64 * db + 8 * C::RSV)));
    }
    FA_SB();
    if constexpr (BAND) {
#pragma unroll
        for (int kb = 0; kb < 2; ++kb)
#pragma unroll
            for (int r = 0; r < 16; ++r) { const int d = qidx - (kidx0 + 32 * kb + crow(r, h)); if (d > 64 || d < -64) p[kb][r] = -1e30f; }
    }
    float mx = __builtin_fmaxf(__builtin_fmaxf(p[0][0], p[1][0]), p[0][1]);
    float my = __builtin_fmaxf(__builtin_fmaxf(p[1][1], p[0][2]), p[1][2]);
#pragma unroll
    for (int r = 3; r < 15; r += 2) { mx = __builtin_fmaxf(__builtin_fmaxf(mx, p[0][r]), p[1][r]); my = __builtin_fmaxf(__builtin_fmaxf(my, p[0][r + 1]), p[1][r + 1]); }
    mx = __builtin_fmaxf(__builtin_fmaxf(mx, p[0][15]), __builtin_fmaxf(my, p[1][15]));
    mx = swap_max(mx);
    if (first || __any(mx > 8.0f)) {
        const float d = first ? mx : __builtin_fmaxf(mx, 0.f);
        if (!first) {
            const float a = __builtin_amdgcn_exp2f(-d); l *= a;
#pragma unroll
            for (int db = 0; db < C::NO; ++db)
#pragma unroll
                for (int r = 0; r < 16; ++r) o[db][r] *= a;
        }
        m += d;
#pragma unroll
        for (int kb = 0; kb < 2; ++kb)
#pragma unroll
            for (int r = 0; r < 16; ++r) p[kb][r] -= d;
#pragma unroll
        for (int r = 0; r < 16; ++r) negm[r] = -m;
    }
    u32x4 pk[2][2];
    float ls0 = 0.f, ls1 = 0.f;
#pragma unroll
    for (int kb = 0; kb < 2; ++kb)
#pragma unroll
        for (int r = 0; r < 16; r += 2) { const float e0 = __builtin_amdgcn_exp2f(p[kb][r]), e1 = __builtin_amdgcn_exp2f(p[kb][r + 1]); ls0 += e0; ls1 += e1; pk[kb][r >> 3][(r >> 1) & 3] = cvtpk(e0, e1); }
    l += ls0 + ls1;
    FA_SB();
#pragma unroll
    for (int s = 0; s < 4; ++s) {
        if (s + 1 < 4) {
            const int off = (32 * ((s + 1) >> 1) + 16 * ((s + 1) & 1)) * C::RSV;
#pragma unroll
            for (int db = 0; db < C::NO; ++db) {
                vlo[(s + 1) & 1][db] = __builtin_bit_cast(s16x4, __builtin_amdgcn_ds_read_tr16_b64_v4i16((FA_LAS s16x4*)(vp + off + 64 * db)));
                vhi[(s + 1) & 1][db] = __builtin_bit_cast(s16x4, __builtin_amdgcn_ds_read_tr16_b64_v4i16((FA_LAS s16x4*)(vp + off + 64 * db + 8 * C::RSV)));
            }
        }
        FA_SB();
        __builtin_amdgcn_s_setprio(1);
#pragma unroll
        for (int db = 0; db < C::NO; ++db) {
            const s16x4 lo = vlo[s & 1][db], hi = vhi[s & 1][db];
            const bf16x8 vf = {lo[0], lo[1], lo[2], lo[3], hi[0], hi[1], hi[2], hi[3]};
            o[db] = __builtin_amdgcn_mfma_f32_32x32x16_bf16(vf, __builtin_bit_cast(bf16x8, pk[s >> 1][s & 1]), o[db], 0, 0, 0);
        }
        __builtin_amdgcn_s_setprio(0);
        FA_SB();
    }
}
template <int DQK, int DV, int KT> __device__ __forceinline__ void store_k(FA_LAS char* kst, int tid, const Regs<DQK, DV, KT>& R) {
    using C = Cfg<DQK, DV, KT>;
#pragma unroll
    for (int i = 0; i < KT / 64; ++i) { const int r = (tid >> 3) + 64 * i, c = tid & 7; *(FA_LAS u32x4*)(kst + r * C::RSK + c * 16) = R.k[i]; }
    if constexpr (DQK == 96) { if (KT == 128 || tid < 256) { const int r = tid >> 2, c = tid & 3; *(FA_LAS u32x4*)(kst + r * C::RSK + 128 + c * 16) = R.k2; } }
}
template <int DQK, int DV, int KT> __device__ __forceinline__ void store_v(FA_LAS char* vst, int tid, const Regs<DQK, DV, KT>& R) {
    using C = Cfg<DQK, DV, KT>;
    if constexpr (DV == 128) {
#pragma unroll
        for (int i = 0; i < 2 * (KT / 64); ++i) { const int r = (tid >> 4) + 32 * i, c = tid & 15; *(FA_LAS u32x4*)(vst + r * C::RSV + c * 16) = R.v[i]; }
    } else {
#pragma unroll
        for (int i = 0; i < KT / 64; ++i) { const int r = (tid >> 3) + 64 * i, c = tid & 7; *(FA_LAS u32x4*)(vst + r * C::RSV + c * 16) = R.v[i]; }
    }
}
template <int DQK, int DV, bool BAND, int KT>
__device__ __forceinline__ void flash_pass(FA_LAS char* lds, const Src& s, int t0, int t1, const bf16x8 (&qf)[DQK / 16], f32x16 (&o)[DV / 32], float& m, float& l, int qidx, int wlo, int whi) {
    using C = Cfg<DQK, DV, KT>;
    int tid_ = threadIdx.x; asm volatile("" : "+v"(tid_));
    const int tid = tid_, lane = tid & 63;
    Regs<DQK, DV, KT> R;
    f32x16 negm;
#pragma unroll
    for (int r = 0; r < 16; ++r) negm[r] = 0.f;
    m = 0.f;
    const int tfirst = BAND ? (t0 > wlo ? t0 : wlo) : t0;
    tile_load<DQK, DV, KT>(s, t0, tid, R);
    store_k<DQK, DV, KT>(lds, tid, R); store_v<DQK, DV, KT>(lds + C::KBYTES, tid, R);
    if (t0 + 1 < t1) tile_load<DQK, DV, KT>(s, t0 + 1, tid, R);
#pragma unroll 1
    for (int t = t0; t < t1; ++t) {
        const int cur = (t - t0) & 1;
        __syncthreads();
        if (!BAND || (t >= wlo && t <= whi)) {
#pragma unroll
            for (int sub = 0; sub < KT / 64; ++sub)
                tile_compute<DQK, DV, BAND>(lds + cur * C::STAGE + sub * 64 * C::RSK, lds + cur * C::STAGE + C::KBYTES + sub * 64 * C::RSV, qf, o, m, l, negm, t == tfirst && sub == 0, lane, qidx, t * KT + sub * 64);
        }
        if (t + 1 < t1) { FA_LAS char* nx = lds + (cur ^ 1) * C::STAGE; store_k<DQK, DV, KT>(nx, tid, R); store_v<DQK, DV, KT>(nx + C::KBYTES, tid, R); if (t + 2 < t1) tile_load<DQK, DV, KT>(s, t + 2, tid, R); }
    }
    __syncthreads();
}
constexpr float LOG2E = 1.4426950408889634f;

__device__ __forceinline__ void diff_unit(FA_LAS char* lds, const bf16_t* QKV, bf16_t* OB, int b, int hh, int qb, float lam, float post, const float* subln) {
    int tid_ = threadIdx.x; asm volatile("" : "+v"(tid_));
    const int tid = tid_, lane = tid & 63, w = tid >> 6, r32 = lane & 31, h = lane >> 5;
    const size_t tok = (size_t)b * 4096 + qb * 256 + w * 32 + r32;
    FA_LAS u32x4* stash = (FA_LAS u32x4*)(lds + 65536) + tid;
    f32x16 oa[4];
#pragma unroll 1
    for (int map = 0; map < 2; ++map) {
        const int head = 2 * hh + map;
        bf16x8 qf[4];
#pragma unroll
        for (int dd = 0; dd < 4; ++dd) qf[dd] = *(const bf16x8*)(QKV + tok * 3072 + head * 64 + dd * 16 + h * 8);
        const bf16_t* base = QKV + (size_t)b * 4096 * 3072;
        const Src s{base + 1024 + head * 64, 3072, nullptr, 0, base + 2048 + hh * 128, 3072};
#pragma unroll
        for (int db = 0; db < 4; ++db)
#pragma unroll
            for (int r = 0; r < 16; ++r) oa[db][r] = 0.f;
        float m = -1e30f, l = 0.f;
        flash_pass<64, 128, false, 64>(lds, s, 0, 64, qf, oa, m, l, 0, 0, 0);
        const float inv = 1.0f / swap_sum(l);
        if (map == 0) {
#pragma unroll
            for (int db = 0; db < 4; ++db)
#pragma unroll
                for (int r = 0; r < 16; r += 8) { u32x4 w; w.x = cvtpk(oa[db][r] * inv, oa[db][r + 1] * inv); w.y = cvtpk(oa[db][r + 2] * inv, oa[db][r + 3] * inv); w.z = cvtpk(oa[db][r + 4] * inv, oa[db][r + 5] * inv); w.w = cvtpk(oa[db][r + 6] * inv, oa[db][r + 7] * inv); stash[(db * 2 + (r >> 3)) * 512] = w; }
        } else {
            const float c = lam * inv;
#pragma unroll
            for (int db = 0; db < 4; ++db)
#pragma unroll
                for (int r = 0; r < 16; r += 8) { const u32x4 w4 = stash[(db * 2 + (r >> 3)) * 512];
#pragma unroll
                    for (int e = 0; e < 4; ++e) { const unsigned w = w4[e]; oa[db][r + 2 * e] = __uint_as_float(w << 16) - oa[db][r + 2 * e] * c; oa[db][r + 2 * e + 1] = __uint_as_float(w & 0xffff0000u) - oa[db][r + 2 * e + 1] * c; } }
        }
    }
    float ss = 0.f;
#pragma unroll
    for (int db = 0; db < 4; ++db)
#pragma unroll
        for (int r = 0; r < 16; ++r) ss += oa[db][r] * oa[db][r];
    ss = swap_sum(ss);
    const float rinv = __builtin_amdgcn_rsqf(ss * (1.0f / 128.0f) + 1e-6f) * post;
    bf16_t* orow = OB + tok * 1024 + hh * 128;
#pragma unroll
    for (int db = 0; db < 4; ++db)
#pragma unroll
        for (int g4 = 0; g4 < 4; ++g4) {
            const int d0 = 32 * db + 8 * g4 + 4 * h;
            const f32x4 sg = *(const f32x4*)(subln + d0);
            u32x2 wv; wv.x = cvtpk(oa[db][4 * g4] * rinv * sg[0], oa[db][4 * g4 + 1] * rinv * sg[1]); wv.y = cvtpk(oa[db][4 * g4 + 2] * rinv * sg[2], oa[db][4 * g4 + 3] * rinv * sg[3]);
            *(u32x2*)(orow + d0) = wv;
        }
}
__device__ __forceinline__ void mla_unit(FA_LAS char* lds, const bf16_t* Q, const bf16_t* KV, const bf16_t* KR, bf16_t* OB, int b, int hd, int qb) {
    int tid_ = threadIdx.x; asm volatile("" : "+v"(tid_));
    const int tid = tid_, lane = tid & 63, w = tid >> 6, r32 = lane & 31, h = lane >> 5;
    const size_t tok = (size_t)b * 4096 + qb * 256 + w * 32 + r32;
    bf16x8 qf[6];
#pragma unroll
    for (int dd = 0; dd < 6; ++dd) qf[dd] = *(const bf16x8*)(Q + tok * 1536 + hd * 96 + dd * 16 + h * 8);
    const bf16_t* kvb = KV + (size_t)b * 4096 * 2048 + hd * 128;
    const Src s{kvb, 2048, KR + (size_t)b * 4096 * 32, 32, kvb + 64, 2048};
    f32x16 o[2];
#pragma unroll
    for (int db = 0; db < 2; ++db)
#pragma unroll
        for (int r = 0; r < 16; ++r) o[db][r] = 0.f;
    float m = -1e30f, l = 0.f;
    flash_pass<96, 64, false, 64>(lds, s, 0, 64, qf, o, m, l, 0, 0, 0);
    const float inv = 1.0f / swap_sum(l);
    bf16_t* orow = OB + tok * 1024 + hd * 64;
#pragma unroll
    for (int db = 0; db < 2; ++db)
#pragma unroll
        for (int g4 = 0; g4 < 4; ++g4) {
            const int d0 = 32 * db + 8 * g4 + 4 * h;
            u32x2 wv; wv.x = cvtpk(o[db][4 * g4] * inv, o[db][4 * g4 + 1] * inv); wv.y = cvtpk(o[db][4 * g4 + 2] * inv, o[db][4 * g4 + 3] * inv);
            *(u32x2*)(orow + d0) = wv;
        }
}
__device__ __forceinline__ void dil_unit(FA_LAS char* lds, const bf16_t* QKV, bf16_t* OB, float* LSE, int b, int hd, int dil, int p, int q0, bool first) {
    int tid_ = threadIdx.x; asm volatile("" : "+v"(tid_));
    const int tid = tid_, lane = tid & 63, w = tid >> 6, r32 = lane & 31, h = lane >> 5;
    const int qidx = q0 + w * 32 + r32;
    const size_t tok = (size_t)b * 4096 + (size_t)qidx * dil + p;
    bf16x8 qf[4];
#pragma unroll
    for (int dd = 0; dd < 4; ++dd) qf[dd] = *(const bf16x8*)(QKV + tok * 3072 + hd * 64 + dd * 16 + h * 8);
    const bf16_t* base = QKV + ((size_t)b * 4096 + p) * 3072 + hd * 64;
    const Src s{base + 1024, (size_t)3072 * dil, nullptr, 0, base + 2048, (size_t)3072 * dil};
    const int nb = 64 / dil, blk0 = q0 >> 6;
    const int t0 = blk0 > 0 ? blk0 - 1 : 0, t1 = (blk0 + 5 < nb) ? blk0 + 5 : nb;
    const int wb = blk0 + (w >> 1);
    f32x16 o[2];
#pragma unroll
    for (int db = 0; db < 2; ++db)
#pragma unroll
        for (int r = 0; r < 16; ++r) o[db][r] = 0.f;
    float m = -1e30f, l = 0.f;
    flash_pass<64, 64, true, 64>(lds, s, t0, t1, qf, o, m, l, qidx, wb - 1, wb + 1);
    const float lt = swap_sum(l);
    const float lse = m + __builtin_amdgcn_logf(lt);
    float wn = 1.0f / lt, wo = 0.f, lse_new = lse;
    float* lp = LSE + tok * 16 + hd;
    if (!first) {
        const float lo_ = *lp; const float mx = __builtin_fmaxf(lo_, lse);
        const float eo = __builtin_amdgcn_exp2f(lo_ - mx), en = __builtin_amdgcn_exp2f(lse - mx), tot = eo + en;
        wo = eo / tot; wn = en / (tot * lt); lse_new = mx + __builtin_amdgcn_logf(tot);
    }
    if (h == 0) *lp = lse_new;
    bf16_t* orow = OB + tok * 1024 + hd * 64;
#pragma unroll
    for (int db = 0; db < 2; ++db)
#pragma unroll
        for (int g4 = 0; g4 < 4; ++g4) {
            const int d0 = 32 * db + 8 * g4 + 4 * h;
            float v0 = o[db][4 * g4] * wn, v1 = o[db][4 * g4 + 1] * wn, v2 = o[db][4 * g4 + 2] * wn, v3 = o[db][4 * g4 + 3] * wn;
            if (!first) { const u32x2 ov = *(const u32x2*)(orow + d0);
                v0 += wo * bf2f((unsigned short)(ov.x & 0xffffu)); v1 += wo * bf2f((unsigned short)(ov.x >> 16)); v2 += wo * bf2f((unsigned short)(ov.y & 0xffffu)); v3 += wo * bf2f((unsigned short)(ov.y >> 16)); }
            u32x2 wv; wv.x = cvtpk(v0, v1); wv.y = cvtpk(v2, v3);
            *(u32x2*)(orow + d0) = wv;
        }
}
struct Regs2 { u32x4 k[2], v[2]; };
__device__ __forceinline__ void dil2_load(const Src& s, int tile, int tl, Regs2& R) {
    const char* kb_ = (const char*)s.k + (size_t)tile * 128 * s.kpitch;
    const char* vb_ = (const char*)s.v + (size_t)tile * 128 * s.vpitch;
#pragma unroll
    for (int i = 0; i < 2; ++i) {
        const unsigned offk = (unsigned)((tl >> 3) + 32 * i) * (unsigned)(s.kpitch * 2) + (unsigned)(tl & 7) * 16u; R.k[i] = *(const u32x4*)(kb_ + offk);
        const unsigned offv = (unsigned)((tl >> 3) + 32 * i) * (unsigned)(s.vpitch * 2) + (unsigned)(tl & 7) * 16u; R.v[i] = *(const u32x4*)(vb_ + offv);
    }
}
__device__ __forceinline__ void dil2_store(FA_LAS char* st, int tl, const Regs2& R) {
    using C = Cfg<64, 64, 64>;
#pragma unroll
    for (int i = 0; i < 2; ++i) { const int r = (tl >> 3) + 32 * i, c = tl & 7;
        *(FA_LAS u32x4*)(st + r * C::RSK + c * 16) = R.k[i]; *(FA_LAS u32x4*)(st + C::KBYTES + r * C::RSV + c * 16) = R.v[i]; }
}
__device__ __forceinline__ void dil2_unit(FA_LAS char* lds, const bf16_t* QKV, bf16_t* OB, float* LSE, int b, int hp, int dil, int p, int q0, bool first) {
    using C = Cfg<64, 64, 64>;
    int tid_ = threadIdx.x; asm volatile("" : "+v"(tid_));
    const int tid = tid_, lane = tid & 63, w = tid >> 6, r32 = lane & 31, h = lane >> 5;
    const int grp = w >> 2, wl = w & 3, tl = tid & 255, hd = 2 * hp + grp;
    FA_LAS char* gl = lds + grp * (2 * C::STAGE);
    const int qidx = q0 + wl * 32 + r32;
    const size_t tok = (size_t)b * 4096 + (size_t)qidx * dil + p;
    bf16x8 qf[4];
#pragma unroll
    for (int dd = 0; dd < 4; ++dd) qf[dd] = *(const bf16x8*)(QKV + tok * 3072 + hd * 64 + dd * 16 + h * 8);
    const bf16_t* base = QKV + ((size_t)b * 4096 + p) * 3072 + hd * 64;
    const Src s{base + 1024, (size_t)3072 * dil, nullptr, 0, base + 2048, (size_t)3072 * dil};
    const int nb = 64 / dil, blk0 = q0 >> 6;
    const int t0 = blk0 > 0 ? blk0 - 1 : 0, t1 = (blk0 + 3 < nb) ? blk0 + 3 : nb;
    const int wb = blk0 + (wl >> 1), wlo = wb - 1, whi = wb + 1;
    f32x16 o[2];
#pragma unroll
    for (int db = 0; db < 2; ++db)
#pragma unroll
        for (int r = 0; r < 16; ++r) o[db][r] = 0.f;
    float m = 0.f, l = 0.f;
    f32x16 negm;
#pragma unroll
    for (int r = 0; r < 16; ++r) negm[r] = 0.f;
    const int tfirst = t0 > wlo ? t0 : wlo;
    Regs2 R;
    dil2_load(s, t0, tl, R);
    dil2_store(gl, tl, R);
    if (t0 + 1 < t1) dil2_load(s, t0 + 1, tl, R);
#pragma unroll 1
    for (int t = t0; t < t1; ++t) {
        const int cur = (t - t0) & 1;
        __syncthreads();
        if (t >= wlo && t <= whi) tile_compute<64, 64, true>(gl + cur * C::STAGE, gl + cur * C::STAGE + C::KBYTES, qf, o, m, l, negm, t == tfirst, lane, qidx, t * 64);
        if (t + 1 < t1) { dil2_store(gl + (cur ^ 1) * C::STAGE, tl, R); if (t + 2 < t1) dil2_load(s, t + 2, tl, R); }
    }
    __syncthreads();
    const float lt = swap_sum(l);
    const float lse = m + __builtin_amdgcn_logf(lt);
    float wn = 1.0f / lt, wo = 0.f, lse_new = lse;
    float* lp = LSE + tok * 16 + hd;
    if (!first) {
        const float lo_ = *lp; const float mx = __builtin_fmaxf(lo_, lse);
        const float eo = __builtin_amdgcn_exp2f(lo_ - mx), en = __builtin_amdgcn_exp2f(lse - mx), tot = eo + en;
        wo = eo / tot; wn = en / (tot * lt); lse_new = mx + __builtin_amdgcn_logf(tot);
    }
    if (h == 0) *lp = lse_new;
    bf16_t* orow = OB + tok * 1024 + hd * 64;
#pragma unroll
    for (int db = 0; db < 2; ++db)
#pragma unroll
        for (int g4 = 0; g4 < 4; ++g4) {
            const int d0 = 32 * db + 8 * g4 + 4 * h;
            float v0 = o[db][4 * g4] * wn, v1 = o[db][4 * g4 + 1] * wn, v2 = o[db][4 * g4 + 2] * wn, v3 = o[db][4 * g4 + 3] * wn;
            if (!first) { const u32x2 ov = *(const u32x2*)(orow + d0);
                v0 += wo * bf2f((unsigned short)(ov.x & 0xffffu)); v1 += wo * bf2f((unsigned short)(ov.x >> 16)); v2 += wo * bf2f((unsigned short)(ov.y & 0xffffu)); v3 += wo * bf2f((unsigned short)(ov.y >> 16)); }
            u32x2 wv; wv.x = cvtpk(v0, v1); wv.y = cvtpk(v2, v3);
            *(u32x2*)(orow + d0) = wv;
        }
}
}
#define GAS __attribute__((address_space(1)))
#define LAS __attribute__((address_space(3)))
typedef unsigned short bf16;
typedef unsigned v4u __attribute__((ext_vector_type(4)));
typedef float f32x4 __attribute__((ext_vector_type(4)));

constexpr int NWAVES = 8;
constexpr int T = 32768, SEQ = 4096, D = 1024, FF = 2816;
constexpr size_t MiB = 1u << 20;
constexpr size_t WS_SSQ = 0, SSQ_BYTES = 2 * MiB;
constexpr size_t WS_ROPEA = 2 * MiB;
constexpr size_t WS_ROPEB = 2 * MiB + 256 * 1024;
constexpr size_t WS_W = 4 * MiB;
constexpr size_t W_AQKV = WS_W;
constexpr size_t W_AWO = W_AQKV + 2 * (size_t)3072 * 1024 * 2;
constexpr size_t W_BWA = W_AWO + 2 * (size_t)1024 * 1024 * 2;
constexpr size_t W_BQB = W_BWA + (size_t)768 * 1024 * 2;
constexpr size_t W_BKVB = W_BQB + (size_t)1536 * 384 * 2;
constexpr size_t W_BWO = W_BKVB + (size_t)2048 * 256 * 2;
constexpr size_t W_CQKV = W_BWO + (size_t)1024 * 1024 * 2;
constexpr size_t W_CWO = W_CQKV + (size_t)9216 * 1024 * 2;
constexpr size_t W_GU = W_CWO + (size_t)1024 * 1024 * 2;
constexpr size_t W_OUT = W_GU + 4 * (size_t)5632 * 1024 * 2;
constexpr size_t W_END = W_OUT + 4 * (size_t)1024 * 2816 * 2;
static_assert(W_END <= 112 * MiB, "weights");
constexpr size_t WS_XB = 112 * MiB;
constexpr size_t WS_OB = 176 * MiB;
constexpr size_t WS_QKV = 240 * MiB;
constexpr size_t WS_MLAKV = WS_QKV + (size_t)T * 1536 * 2;
constexpr size_t WS_MLAKR = WS_MLAKV + (size_t)T * 2048 * 2;
constexpr size_t WS_LSE = 496 * MiB;
constexpr size_t WS_SSQ2 = 498 * MiB, SSQ2_BYTES = 3 * MiB;
constexpr size_t WS_END = 502 * MiB;
static_assert(WS_MLAKR + (size_t)T * 32 * 2 <= WS_LSE, "qkv region");

constexpr int LDS_BYTES = 131072 + 256;

struct Params {
    const float* in[21];
    float* out; unsigned char* ws;
};

__device__ __forceinline__ unsigned f2bf(float f) { unsigned u = __builtin_bit_cast(unsigned, f); return (u + 0x7fffu + ((u >> 16) & 1u)) >> 16; }
__device__ __forceinline__ unsigned pk2(float lo, float hi) { return f2bf(lo) | (f2bf(hi) << 16); }
__device__ __forceinline__ float wave_sum(float v) {
#pragma unroll
    for (int o = 1; o < 64; o <<= 1) v += __shfl_xor(v, o);
    return v;
}
__device__ __forceinline__ void transpose_item(const float* W, int K, int N, bf16* WT, const float* gain, int mode, LAS float* scr, int item, int lane) {
    const int nblk = N / 32, kb = item / nblk, nb = item % nblk, k0 = 64 * kb, n0 = 32 * nb;
    f32x4 v[8];
#pragma unroll
    for (int i = 0; i < 8; ++i) { const int kk = (lane >> 3) + 8 * i; v[i] = *(const f32x4*)(W + (size_t)(k0 + kk) * N + n0 + 4 * (lane & 7)); }
#pragma unroll
    for (int i = 0; i < 8; ++i) { const int kk = (lane >> 3) + 8 * i; const float g = gain ? gain[k0 + kk] : 1.0f; LAS float* d = scr + kk * 33 + 4 * (lane & 7);
        d[0] = v[i].x * g; d[1] = v[i].y * g; d[2] = v[i].z * g; d[3] = v[i].w * g; }
    asm volatile("s_waitcnt lgkmcnt(0)" ::: "memory");
    int d0 = n0;
    if (mode == 1) { const int f = n0 < FF ? n0 : n0 - FF; d0 = 256 * (f / 128) + (f % 128) + (n0 < FF ? 0 : 128); }
    const int c = lane & 7;
#pragma unroll
    for (int j = 0; j < 4; ++j) { const int n = (lane >> 3) + 8 * j; const LAS float* s = scr + (8 * c) * 33 + n;
        v4u o; o.x = pk2(s[0 * 33], s[1 * 33]); o.y = pk2(s[2 * 33], s[3 * 33]); o.z = pk2(s[4 * 33], s[5 * 33]); o.w = pk2(s[6 * 33], s[7 * 33]);
        *(v4u*)(WT + (size_t)(d0 + n) * K + k0 + 8 * c) = o; }
    asm volatile("s_waitcnt lgkmcnt(0)" ::: "memory");
}
__device__ __forceinline__ void sincos_d(float ang, float& sn, float& cs) {
    double t = (double)ang * 0.15915494309189535; t -= __builtin_rint(t);
    const double r = t * 6.283185307179586, r2 = r * r;
    double s = 1.0 / 51090942171709440000.0, c = 1.0 / 2432902008176640000.0;
    s = s * r2 * -1.0 + 1.0 / 121645100408832000.0;  c = c * r2 * -1.0 + 1.0 / 6402373705728000.0;
    s = s * r2 * -1.0 + 1.0 / 355687428096000.0;     c = c * r2 * -1.0 + 1.0 / 20922789888000.0;
    s = s * r2 * -1.0 + 1.0 / 1307674368000.0;       c = c * r2 * -1.0 + 1.0 / 87178291200.0;
    s = s * r2 * -1.0 + 1.0 / 6227020800.0;          c = c * r2 * -1.0 + 1.0 / 479001600.0;
    s = s * r2 * -1.0 + 1.0 / 39916800.0;            c = c * r2 * -1.0 + 1.0 / 3628800.0;
    s = s * r2 * -1.0 + 1.0 / 362880.0;              c = c * r2 * -1.0 + 1.0 / 40320.0;
    s = s * r2 * -1.0 + 1.0 / 5040.0;                c = c * r2 * -1.0 + 1.0 / 720.0;
    s = s * r2 * -1.0 + 1.0 / 120.0;                 c = c * r2 * -1.0 + 1.0 / 24.0;
    s = s * r2 * -1.0 + 1.0 / 6.0;                   c = c * r2 * -1.0 + 1.0 / 2.0;
    s = s * r2 * -1.0 + 1.0;                         c = c * r2 * -1.0 + 1.0;
    sn = (float)(s * r); cs = (float)c;
}

typedef GAS unsigned gu32;
constexpr size_t WS_BAR = WS_SSQ2 + SSQ2_BYTES;
#define XB_TMO      128
#define XB_XCNT(j)  (256  + 64 * (j))
#define XB_XSUB(j)  (1280 + 64 * (j))
#define XB_XGEN(j)  (2304 + 64 * (j))
#define XB_TOP      3328
#define XB_TOPGEN   3392
#define XCD_BAR_WORDS 3456
#define XB_SPIN_CAP (1u << 18)

__device__ __forceinline__ unsigned xb_ld(unsigned* p)              { return __hip_atomic_load(p, __ATOMIC_RELAXED, __HIP_MEMORY_SCOPE_AGENT); }
__device__ __forceinline__ unsigned xb_add(unsigned* p, unsigned v) { return __hip_atomic_fetch_add(p, v, __ATOMIC_RELAXED, __HIP_MEMORY_SCOPE_AGENT); }
__device__ __forceinline__ unsigned xb_xcc_id() { return (unsigned)__builtin_amdgcn_s_getreg((3 << 11) | 20) & 0xFu; }
#define XB_SPIN(cond, bar) do { unsigned _sp = 0; while (cond) { __builtin_amdgcn_s_sleep(1); \
    if ((++_sp & 255u) == 0u) { if (xb_ld(&(bar)[XB_TMO])) break; if (_sp > XB_SPIN_CAP) { atomicAdd(&(bar)[XB_TMO], 1u); break; } } } } while (0)

struct XcdBarrier {
    unsigned* bar; unsigned x;
    volatile LAS unsigned* st;
};

__device__ __forceinline__ XcdBarrier xcd_barrier_post(unsigned* bar, volatile LAS unsigned* st) {
    XcdBarrier b; b.bar = bar; b.x = xb_xcc_id(); b.st = st;
    if (threadIdx.x == 0) (void)xb_add(&bar[XB_XCNT(b.x)], 1u);
    return b;
}
__device__ __forceinline__ void xcd_barrier_complete(unsigned* bar, unsigned x, unsigned& nloc, unsigned& nx) {
    const unsigned G = gridDim.x * gridDim.y * gridDim.z;
    unsigned sum, cnt, mine, sp = 0u;
    for (;;) {
        sum = 0u; cnt = 0u; mine = 0u;
#pragma unroll
        for (unsigned j = 0; j < 16; ++j) { const unsigned c = xb_ld(&bar[XB_XCNT(j)]); sum += c; cnt += (c > 0u) ? 1u : 0u; mine = (j == x) ? c : mine; }
        if (sum == G) break;
        __builtin_amdgcn_s_sleep(1);
        if ((++sp & 255u) == 0u) { if (xb_ld(&bar[XB_TMO])) break; if (sp > XB_SPIN_CAP) { atomicAdd(&bar[XB_TMO], 1u); break; } }
    }
    nloc = mine > 0u ? mine : 1u; nx = cnt > 0u ? cnt : 1u;
}

__device__ __forceinline__ void xcd_barrier(const XcdBarrier& b) {
    asm volatile("s_waitcnt vmcnt(0)" ::: "memory");
    __syncthreads();
    if (threadIdx.x == 0) {
        unsigned* bar = b.bar;
        __builtin_amdgcn_s_waitcnt(0);
        unsigned nloc = b.st[0], nx = b.st[1];
        if (nloc == 0u) { xcd_barrier_complete(bar, b.x, nloc, nx); b.st[0] = nloc; b.st[1] = nx; }
        const unsigned old = xb_add(&bar[XB_XSUB(b.x)], 1u);
        const unsigned gen = old / nloc;
        if (old + 1u == (gen + 1u) * nloc) {
            __builtin_amdgcn_fence(__ATOMIC_RELEASE, "agent");
            asm volatile("s_waitcnt vmcnt(0)" ::: "memory");
            const unsigned og = xb_add(&bar[XB_TOP], 1u);
            const unsigned tg = og / nx;
            if (og + 1u == (tg + 1u) * nx) xb_add(&bar[XB_TOPGEN], 1u);
            else XB_SPIN(xb_ld(&bar[XB_TOPGEN]) == tg, bar);
            __builtin_amdgcn_fence(__ATOMIC_ACQUIRE, "agent");
            xb_add(&bar[XB_XGEN(b.x)], 1u);
            asm volatile("s_waitcnt vmcnt(0)" ::: "memory");
        } else {
            XB_SPIN(xb_ld(&bar[XB_XGEN(b.x)]) == gen, bar);
            __builtin_amdgcn_fence(__ATOMIC_ACQUIRE, "agent");
            asm volatile("s_waitcnt vmcnt(0)" ::: "memory");
        }
    }
    __syncthreads();
}

template <class E> struct En { static constexpr bool v = true; };
#ifdef OFF_QKV
template <> struct En<pg8::EpiQKV> { static constexpr bool v = false; };
#endif
#ifdef OFF_SCALE
template <> struct En<pg8::EpiScale> { static constexpr bool v = false; };
#endif
#ifdef OFF_MLAQ
template <> struct En<pg8::EpiMlaQ> { static constexpr bool v = false; };
#endif
#ifdef OFF_MLAA
template <> struct En<pg8::EpiMlaA> { static constexpr bool v = false; };
#endif
#ifdef OFF_RES
template <> struct En<pg8::EpiRes> { static constexpr bool v = false; };
#endif
#ifdef OFF_SWI
template <> struct En<pg8::EpiSwiGLU> { static constexpr bool v = false; };
#endif
__global__ void __launch_bounds__(NWAVES * 64) fwd_kernel(Params P) {
    extern __shared__ __attribute__((aligned(16))) unsigned char lds_raw[];
    cg::grid_group grid = cg::this_grid();
    LAS unsigned char* lds = (LAS unsigned char*)lds_raw;
    const int tid = threadIdx.x, lane = tid & 63, wave = __builtin_amdgcn_readfirstlane(tid >> 6);
    const int G = gridDim.x, bx = blockIdx.x;
    if (threadIdx.x < 64) ((LAS unsigned*)(lds + 131072))[threadIdx.x] = 0u;
    __syncthreads();
    XcdBarrier xbar = xcd_barrier_post((unsigned*)(P.ws + WS_BAR), (volatile LAS unsigned*)(lds + 131072));
#define GSYNC() do { XcdBarrier b_ = xbar; asm volatile("" : "+s"(b_.bar), "+s"(b_.x)); xcd_barrier(b_); } while (0)
    const int vcu = (G % 8 == 0) ? (bx % 8) * (G / 8) + bx / 8 : bx;
    unsigned char* ws = P.ws;
    pg8::ssq_t* ssq = (pg8::ssq_t*)(ws + WS_SSQ2);
    float* ropeA = (float*)(ws + WS_ROPEA); float* ropeB = (float*)(ws + WS_ROPEB);
    bf16* XB = (bf16*)(ws + WS_XB); bf16* OB = (bf16*)(ws + WS_OB); bf16* QKV = (bf16*)(ws + WS_QKV);
    bf16* MQ = QKV; bf16* MKV = (bf16*)(ws + WS_MLAKV); bf16* MKR = (bf16*)(ws + WS_MLAKR); bf16* ARAW = OB; bf16* ACT = QKV;
    float* LSE = (float*)(ws + WS_LSE);
    const float* x_in = P.in[0]; const float* attn_norm = P.in[1]; const float* ffn_norm = P.in[2]; const float* final_norm = P.in[3];
    float* out = P.out;

#ifndef PRO_REP
#define PRO_REP 1
#endif
#pragma unroll 1
    for (int rep_ = 0; rep_ < PRO_REP; ++rep_) {
        LAS float* scr = (LAS float*)(lds + wave * 16384);
        const int gw = vcu * NWAVES + wave, NGW = G * NWAVES;
        constexpr int NITEMS = (int)(((size_t)2 * 1024 * 3072 + 2 * 1024 * 1024 + 1024 * 672 + 384 * 1536 + 256 * 2048 + 1024 * 1024 + 1024 * 9216 + 1024 * 1024 + (size_t)4 * 1024 * 5632 + (size_t)4 * 2816 * 1024) / 2048);
        for (int it = gw; it < NITEMS; it += NGW) {
            int r = it, rr = 0, K = 0, N = 0, mode = 0; const float* src = nullptr; const float* gain = nullptr; bf16* dst = nullptr;
#define SEL(S_, K_, N_, D_, G_, M_) if (r >= 0) { const int ni = ((K_) / 64) * ((N_) / 32); if (r < ni) { src = (S_); K = (K_); N = (N_); dst = (bf16*)(D_); gain = (G_); mode = (M_); rr = r; r = -1; } else r -= ni; }
            SEL(P.in[4], 1024, 3072, ws + W_AQKV, attn_norm + 0 * 1024, 0)
            SEL(P.in[4] + (size_t)1024 * 3072, 1024, 3072, ws + W_AQKV + (size_t)3072 * 1024 * 2, attn_norm + 3 * 1024, 0)
            SEL(P.in[10], 1024, 1024, ws + W_AWO, nullptr, 0)
            SEL(P.in[10] + (size_t)1024 * 1024, 1024, 1024, ws + W_AWO + (size_t)1024 * 1024 * 2, nullptr, 0)
            SEL(P.in[11], 1024, 672, ws + W_BWA, attn_norm + 1 * 1024, 0)
            SEL(P.in[14], 384, 1536, ws + W_BQB, P.in[12], 0)
            SEL(P.in[15], 256, 2048, ws + W_BKVB, P.in[13], 0)
            SEL(P.in[16], 1024, 1024, ws + W_BWO, nullptr, 0)
            SEL(P.in[17], 1024, 9216, ws + W_CQKV, attn_norm + 2 * 1024, 0)
            SEL(P.in[18], 1024, 1024, ws + W_CWO, nullptr, 0)
#pragma unroll
            for (int i = 0; i < 4; ++i) { SEL(P.in[19] + (size_t)i * 1024 * 5632, 1024, 5632, ws + W_GU + (size_t)i * 5632 * 1024 * 2, ffn_norm + i * 1024, 1) }
#pragma unroll
            for (int i = 0; i < 4; ++i) { SEL(P.in[20] + (size_t)i * 2816 * 1024, 2816, 1024, ws + W_OUT + (size_t)i * 1024 * 2816 * 2, nullptr, 0) }
#undef SEL
            transpose_item(src, K, N, dst, gain, mode, scr, rr, lane);
        }
        { v4u* z = (v4u*)(ws + W_BWA + (size_t)672 * 1024 * 2); const int nz = 96 * 1024 * 2 / 16; for (int i = bx * 512 + tid; i < nz; i += G * 512) z[i] = (v4u){0u, 0u, 0u, 0u}; }
        for (int i = bx * 512 + tid; i < 4096 * 24; i += G * 512) {
            const int pos = i / 24, j = i % 24; float sn, cs;
            if (j < 8) { const float inv = (float)exp2(-(double)j * (1.0 / 8.0) * 18.931568569324174); sincos_d((float)pos * inv, sn, cs); ropeA[pos * 16 + j] = cs; ropeA[pos * 16 + 8 + j] = sn; }
            else { const int jj = j - 8; const float inv = (float)exp2(-(double)jj * (1.0 / 16.0) * 18.931568569324174); sincos_d((float)pos * inv, sn, cs); ropeB[pos * 32 + jj] = cs; ropeB[pos * 32 + 16 + jj] = sn; }
        }
        for (int m = gw; m < T; m += NGW) {
            const f32x4* xr = (const f32x4*)(x_in + (size_t)m * D) + lane; f32x4 v[4]; float s = 0.f;
#pragma unroll
            for (int j = 0; j < 4; ++j) { v[j] = xr[64 * j]; s += (v[j].x * v[j].x + v[j].y * v[j].y) + (v[j].z * v[j].z + v[j].w * v[j].w); }
            s = wave_sum(s); if (lane == 0) ssq[m] = (pg8::ssq_t)(unsigned)(s * 65536.0f + 0.5f);
            unsigned long long* o8 = (unsigned long long*)(XB + (size_t)m * D) + lane;
#pragma unroll
            for (int j = 0; j < 4; ++j) o8[64 * j] = (unsigned long long)pk2(v[j].x, v[j].y) | ((unsigned long long)pk2(v[j].z, v[j].w) << 32);
        }
    }
    if (P.ws == nullptr) grid.sync();
    GSYNC();

    const float QS64 = 0.125f * fa::LOG2E, QS96 = 0.10206207261596577f * fa::LOG2E;
#ifndef NO_GEMM
#define GEMM_CALL(EPI, e_) if constexpr (En<EPI>::v) pg8::gemm_phase<EPI, pg8::StaticOrder, true, true>(lds, g_, S_, e_);
#else
#define GEMM_CALL(EPI, e_) (void)e_;
#endif
#define GEMM_PHASE(EPI, e_, A_, B_, N_, K_, lda_, ldb_) do { const pg8::bf16_t* pa_ = (const pg8::bf16_t*)(A_); const pg8::bf16_t* pb_ = (const pg8::bf16_t*)(B_); int c_ = bx; asm volatile("" : "+s"(pa_), "+s"(pb_), "+s"(c_)); \
        pg8::Gemm g_{pa_, pb_, T, (N_), (K_), (lda_), (ldb_)}; pg8::StaticOrder S_; S_.init(T, (N_), G, c_); \
        GEMM_CALL(EPI, e_) } while (0)

#pragma unroll 1
    for (int layer = 0; layer < 4; ++layer) {
        const int mix = layer % 3, j = layer / 3;
        const float* x_old = layer == 0 ? x_in : out;
        pg8::ssq_t* ssq_attn = ssq + (size_t)(2 * layer) * T; pg8::ssq_t* ssq_ffn = ssq + (size_t)(2 * layer + 1) * T; pg8::ssq_t* ssq_next = ssq + (size_t)(2 * layer + 2) * T;
        const bf16* wo_t;
        if (mix == 0) {
            { pg8::EpiQKV E{QKV, ssq_attn, ropeA, QS64}; GEMM_PHASE(pg8::EpiQKV, E, XB, ws + W_AQKV + (size_t)j * 3072 * 1024 * 2, 3072, 1024, 1024, 1024); }
#ifdef PROBE_QKV2
            { pg8::EpiQKV E{QKV, ssq_attn, ropeA, QS64}; GEMM_PHASE(pg8::EpiQKV, E, XB, ws + W_AQKV + (size_t)j * 3072 * 1024 * 2, 3072, 1024, 1024, 1024); }
#endif
            GSYNC();
            {
                const float* lq1 = P.in[5] + j * 64; const float* lk1 = P.in[6] + j * 64; const float* lq2 = P.in[7] + j * 64; const float* lk2 = P.in[8] + j * 64;
                float s1 = 0.f, s2 = 0.f;
                for (int i = 0; i < 64; ++i) { s1 += lq1[i] * lk1[i]; s2 += lq2[i] * lk2[i]; }
                const float lam_init = 0.8f - 0.6f * expf(-0.3f * (float)layer);
                const float lam = expf(s1) - expf(s2) + lam_init;
                const int total = 8 * 8 * 16, per = (total + G - 1) / G;
                for (int i = 0; i < per; ++i) { const int uid = vcu * per + i; if (uid >= total) break; const int bh = uid >> 4, qb = uid & 15;

#ifndef NO_DIFF
 fa::diff_unit((FA_LAS char*)lds, QKV, OB, bh >> 3, bh & 7, qb, lam, 1.0f - lam_init, P.in[9] + j * 128);
#ifdef PROBE_DIFF2
 fa::diff_unit((FA_LAS char*)lds, QKV, OB, bh >> 3, bh & 7, qb, lam, 1.0f - lam_init, P.in[9] + j * 128);
#endif
#endif
 }
            }
            wo_t = (const bf16*)(ws + W_AWO + (size_t)j * 1024 * 1024 * 2);
        } else if (mix == 1) {
            pg8::ssq_t* ssq_q = ssq + (size_t)9 * T; pg8::ssq_t* ssq_kv = ssq + (size_t)10 * T;
            { pg8::EpiMlaA E{ARAW, MKR, ssq_attn, ssq_q, ssq_kv, ropeB}; GEMM_PHASE(pg8::EpiMlaA, E, XB, ws + W_BWA, 768, 1024, 1024, 1024); }
            GSYNC();
            { pg8::EpiMlaQ E{MQ, ssq_q, ropeB, QS96}; GEMM_PHASE(pg8::EpiMlaQ, E, ARAW, ws + W_BQB, 1536, 384, 768, 384); }
            { pg8::EpiScale E{MKV, 2048, ssq_kv, 1.0f / 256.0f}; GEMM_PHASE(pg8::EpiScale, E, ARAW + 384, ws + W_BKVB, 2048, 256, 768, 256); }
            GSYNC();
            {
                const int total = 8 * 16 * 16, per = (total + G - 1) / G;
                for (int i = 0; i < per; ++i) { const int uid = vcu * per + i; if (uid >= total) break; const int bh = uid >> 4, qb = uid & 15;

#ifndef NO_MLA
 fa::mla_unit((FA_LAS char*)lds, MQ, MKV, MKR, OB, bh >> 4, bh & 15, qb);
#ifdef PROBE_MLA2
 fa::mla_unit((FA_LAS char*)lds, MQ, MKV, MKR, OB, bh >> 4, bh & 15, qb);
#endif
#endif
 }
            }
            wo_t = (const bf16*)(ws + W_BWO);
        } else {
#pragma unroll 1
            for (int g = 0; g < 3; ++g) {
                const int dil = g == 0 ? 1 : (g == 1 ? 4 : 16);
                { pg8::EpiQKV E{QKV, ssq_attn, ropeA, QS64}; GEMM_PHASE(pg8::EpiQKV, E, XB, ws + W_CQKV + (size_t)g * 3072 * 1024 * 2, 3072, 1024, 1024, 1024); }
#ifdef PROBE_QKV2
                { pg8::EpiQKV E{QKV, ssq_attn, ropeA, QS64}; GEMM_PHASE(pg8::EpiQKV, E, XB, ws + W_CQKV + (size_t)g * 3072 * 1024 * 2, 3072, 1024, 1024, 1024); }
#endif
                GSYNC();
                {
                    const int total = 8 * 8 * 32, per = (total + G - 1) / G, nq = 32 / dil;
                    for (int i = 0; i < per; ++i) { const int uid = vcu * per + i; if (uid >= total) break; const int bh = uid >> 5, sub = uid & 31;
#ifndef NO_DIL
                        fa::dil2_unit((FA_LAS char*)lds, QKV, OB, LSE, bh >> 3, bh & 7, dil, sub / nq, (sub % nq) * 128, g == 0);
#endif
                    }
                }
                if (g < 2) GSYNC();
            }
            wo_t = (const bf16*)(ws + W_CWO);
        }
        GSYNC();
        { pg8::EpiRes E{nullptr, nullptr, XB, 1, ssq_ffn}; GEMM_PHASE(pg8::EpiRes, E, OB, wo_t, 1024, 1024, 1024, 1024); }
        GSYNC();
        { pg8::EpiSwiGLU E{ACT, ssq_ffn}; GEMM_PHASE(pg8::EpiSwiGLU, E, XB, ws + W_GU + (size_t)layer * 5632 * 1024 * 2, 5632, 1024, 1024, 1024); }
#ifdef PROBE_GU2
        { pg8::EpiSwiGLU E{ACT, ssq_ffn}; GEMM_PHASE(pg8::EpiSwiGLU, E, XB, ws + W_GU + (size_t)layer * 5632 * 1024 * 2, 5632, 1024, 1024, 1024); }
#endif
        GSYNC();
        { pg8::EpiRes E{nullptr, nullptr, XB, 1, ssq_next}; GEMM_PHASE(pg8::EpiRes, E, ACT, ws + W_OUT + (size_t)layer * 1024 * 2816 * 2, 1024, 2816, 2816, 2816); }
        GSYNC();
    }
    {
        int tid2 = threadIdx.x; asm volatile("" : "+v"(tid2)); const int lane = tid2 & 63, wave = __builtin_amdgcn_readfirstlane(tid2 >> 6);
        const int gw = vcu * NWAVES + wave, NGW = G * NWAVES; const pg8::ssq_t* sf = ssq + (size_t)8 * T;
        for (int m = gw; m < T; m += NGW) {
            const float rinv = __builtin_amdgcn_rsqf(pg8::ssq_get(sf, m) * (1.0f / 1024.0f) + 1e-6f);
            const v4u* xr = (const v4u*)(XB + (size_t)m * D) + lane; f32x4* orow = (f32x4*)(out + (size_t)m * D); const f32x4* gn = (const f32x4*)final_norm;
#pragma unroll
            for (int jj = 0; jj < 2; ++jj) { const v4u w = xr[64 * jj]; const int c4 = (jj * 512 + 8 * lane) / 4;
                const f32x4 a0 = {__uint_as_float(w.x << 16), __uint_as_float(w.x & 0xffff0000u), __uint_as_float(w.y << 16), __uint_as_float(w.y & 0xffff0000u)};
                const f32x4 a1 = {__uint_as_float(w.z << 16), __uint_as_float(w.z & 0xffff0000u), __uint_as_float(w.w << 16), __uint_as_float(w.w & 0xffff0000u)};
                orow[c4] = a0 * rinv * gn[c4]; orow[c4 + 1] = a1 * rinv * gn[c4 + 1]; }
        }
    }
}

extern "C" void kernel_launch(void* const* d_in, const int* in_sizes, int n_in, void* d_out, int out_size, void* d_ws, size_t ws_size, hipStream_t stream) {
    static int grid = 0;
    if (grid == 0) {
        if (n_in != 21 || in_sizes[0] != T * D || out_size != T * D || ws_size < WS_END) { fprintf(stderr, "kernel_launch: unexpected shapes (n_in %d, ws %zu); nothing launched\n", n_in, ws_size); grid = -1; return; }
        int dev = 0, cus = 0, per_cu = 0;
        hipGetDevice(&dev); hipDeviceGetAttribute(&cus, hipDeviceAttributeMultiprocessorCount, dev);
        if (hipFuncSetAttribute((const void*)fwd_kernel, hipFuncAttributeMaxDynamicSharedMemorySize, LDS_BYTES) != hipSuccess) { fprintf(stderr, "kernel_launch: hipFuncSetAttribute failed\n"); grid = -1; return; }
        if (hipOccupancyMaxActiveBlocksPerMultiprocessor(&per_cu, (const void*)fwd_kernel, NWAVES * 64, LDS_BYTES) != hipSuccess || per_cu < 1) { fprintf(stderr, "kernel_launch: occupancy query gave %d\n", per_cu); per_cu = 1; }
        (void)hipGetLastError();
        grid = cus * per_cu;
    }
    if (grid < 0) return;
    hipMemsetAsync((char*)d_ws + WS_SSQ2, 0, SSQ2_BYTES + 16384, stream);
    Params p{};
    for (int i = 0; i < 21; ++i) p.in[i] = (const float*)d_in[i];
    p.out = (float*)d_out; p.ws = (unsigned char*)d_ws;
    void* args[] = {&p};
    hipError_t e = hipLaunchCooperativeKernel((const void*)fwd_kernel, dim3(grid), dim3(NWAVES * 64), args, LDS_BYTES, stream);
    if (e != hipSuccess) fprintf(stderr, "cooperative launch failed: %s (grid %d)\n", hipGetErrorString(e), grid);
}
```
